# Optimizing an MI355X kernel written in HIP

```python
import math
import jax
import jax.numpy as jnp
from jax import lax
import numpy as np

D_MODEL = 1024
BATCH = 16
SEQ = 2048
DEPTH = 4

GRID_W = 64
CTX_LEN = 256
N_MOD = 6
NORM_EPS = 1e-6
GN_EPS = 64e-5

BRANCH_WIDTH = 512
N_BRANCH = 3

SSM_WIDTH = BRANCH_WIDTH
SSM_GROUP = 16
SSM_GROUPS = SSM_WIDTH // SSM_GROUP
SSM_STATE = 64
SSM_DT_MIN = 1e-3
SSM_DT_MAX = 1e-1

RWKV_WIDTH = BRANCH_WIDTH
RWKV_HEAD = 64
RWKV_HEADS = RWKV_WIDTH // RWKV_HEAD
DECAY_LORA = 64
ICLR_LORA = 64
GATE_LORA = 128
RWKV_IN = 3 * RWKV_WIDTH + 2 * DECAY_LORA + 2 * ICLR_LORA + GATE_LORA
RWKV_SPLITS = (RWKV_WIDTH, 2 * RWKV_WIDTH, 3 * RWKV_WIDTH,
               3 * RWKV_WIDTH + 2 * DECAY_LORA,
               3 * RWKV_WIDTH + 2 * DECAY_LORA + 2 * ICLR_LORA)

MLA_HEADS = 8
MLA_NOPE = 64
MLA_ROPE = 32
MLA_V = BRANCH_WIDTH // MLA_HEADS
Q_LORA = 384
KV_LORA = 256
MLA_IN = Q_LORA + KV_LORA + MLA_ROPE
MLA_SCALE = 1.0 / math.sqrt(MLA_NOPE + MLA_ROPE)
ROPE_AXIS_DIMS = MLA_ROPE // 2
ROPE_BASE = 10000.0
Q_BLOCK = 128

RWKV_OFF = SSM_WIDTH
MLA_OFF = RWKV_OFF + RWKV_IN
GATE_OFF = MLA_OFF + MLA_IN
N_IN = GATE_OFF + N_BRANCH * D_MODEL

N_EXPERTS = 16
EXPERT_FF = 1536
EC_CAPACITY = 2

kernel_name = 'hybrid_s5_rwkv7_mla_ecmoe_diffusion_trunk'


def rmsnorm(x, g):
    xf = x.astype(jnp.float32)
    y = xf * lax.rsqrt(jnp.mean(xf * xf, axis=-1, keepdims=True) + NORM_EPS)
    return (y * g.astype(jnp.float32)).astype(x.dtype)


def modulate(h, shift, scale):
    return h * (1.0 + scale) + shift


def centred_shift(p):
    prev = jnp.pad(p[:, :-1], ((0, 0), (1, 0), (0, 0)))
    nxt = jnp.pad(p[:, 1:], ((0, 0), (0, 1), (0, 0)))
    return 0.5 * (prev + nxt)


def axial_rope(rows):
    row = jnp.repeat(jnp.arange(rows), GRID_W).astype(jnp.float32)
    col = jnp.tile(jnp.arange(GRID_W), rows).astype(jnp.float32)
    inv = ROPE_BASE ** (-jnp.arange(0, ROPE_AXIS_DIMS, 2, dtype=jnp.float32) / ROPE_AXIS_DIMS)
    ang = jnp.concatenate([row[:, None] * inv, col[:, None] * inv], axis=-1)
    return jnp.cos(ang), jnp.sin(ang)


def apply_rope(x, cos, sin):
    half = MLA_ROPE // 2
    x1, x2 = x[..., :half], x[..., half:]
    return jnp.concatenate([x1 * cos - x2 * sin, x1 * sin + x2 * cos], axis=-1).astype(x.dtype)


def ssm_discretise(lam_re, lam_im, log_dt, b_re, b_im):
    f32 = jnp.float32
    lr, li = lam_re.astype(f32), lam_im.astype(f32)
    dt = jnp.exp(log_dt.astype(f32))[:, None]
    mag = jnp.exp(lr * dt)
    abar_re, abar_im = mag * jnp.cos(li * dt), mag * jnp.sin(li * dt)
    den = lr * lr + li * li
    nr, ni = abar_re - 1.0, abar_im
    coef_re = (nr * lr + ni * li) / den
    coef_im = (ni * lr - nr * li) / den
    br, bi = b_re.astype(f32), b_im.astype(f32)
    bbar_re = coef_re[..., None] * br - coef_im[..., None] * bi
    bbar_im = coef_re[..., None] * bi + coef_im[..., None] * br
    return abar_re, abar_im, bbar_re, bbar_im


def _ssm_combine(e1, e2):
    a1r, a1i, b1r, b1i = e1
    a2r, a2i, b2r, b2i = e2
    return (a2r * a1r - a2i * a1i, a2r * a1i + a2i * a1r,
            a2r * b1r - a2i * b1i + b2r, a2r * b1i + a2i * b1r + b2i)


def ssm_scan(u, abar_re, abar_im, bbar_re, bbar_im, reverse, s0_re=None, s0_im=None):
    T = u.shape[1]
    bu_re = jnp.einsum('btgc,gpc->btgp', u, bbar_re)
    bu_im = jnp.einsum('btgc,gpc->btgp', u, bbar_im)
    a_re = jnp.broadcast_to(abar_re, (1, T) + abar_re.shape)
    a_im = jnp.broadcast_to(abar_im, (1, T) + abar_im.shape)
    acc_re, acc_im, x_re, x_im = lax.associative_scan(
        _ssm_combine, (a_re, a_im, bu_re, bu_im), reverse=reverse, axis=1)
    if s0_re is not None:
        s_re, s_im = s0_re[:, None], s0_im[:, None]
        x_re = x_re + acc_re * s_re - acc_im * s_im
        x_im = x_im + acc_re * s_im + acc_im * s_re
    return x_re, x_im


def ssm_readout(x_re, x_im, c_re, c_im):
    return (jnp.einsum('btgp,gcp->btgc', x_re, c_re.astype(jnp.float32))
            - jnp.einsum('btgp,gcp->btgc', x_im, c_im.astype(jnp.float32)))


def ssm_glu(y, glu_w, glu_b):
    B, T = y.shape[:2]
    y = jax.nn.gelu(y.reshape(B, T, SSM_WIDTH))
    return y * jax.nn.sigmoid(y @ glu_w + glu_b)


def ssm_branch(u_ctx, u_lat, lam_re, lam_im, log_dt, b_re, b_im, c_re, c_im, d_skip,
               glu_w, glu_b, with_ctx):
    def groups(u):
        return u.astype(jnp.float32).reshape(u.shape[0], u.shape[1], SSM_GROUPS, SSM_GROUP)
    uc, ul = groups(u_ctx), groups(u_lat)
    d = d_skip.astype(jnp.float32).reshape(SSM_GROUPS, SSM_GROUP)
    y_lat = ul * d
    y_ctx = uc * d if with_ctx else None
    for j, reverse in enumerate((False, True)):
        disc = ssm_discretise(lam_re[j], lam_im[j], log_dt[j], b_re, b_im)
        xc_re, xc_im = ssm_scan(uc, *disc, reverse=reverse)
        end = 0 if reverse else -1
        xl_re, xl_im = ssm_scan(ul, *disc, reverse=reverse,
                                s0_re=xc_re[:, end], s0_im=xc_im[:, end])
        y_lat = y_lat + ssm_readout(xl_re, xl_im, c_re[j], c_im[j])
        if with_ctx:
            y_ctx = y_ctx + ssm_readout(xc_re, xc_im, c_re[j], c_im[j])
    out_lat = ssm_glu(y_lat, glu_w, glu_b)
    out_ctx = ssm_glu(y_ctx, glu_w, glu_b) if with_ctx else None
    return out_ctx, out_lat


def rwkv_prepare(p, mu, w0, w2, a0, a2, g2, k_k, k_a):
    B, T, _ = p.shape
    p = p.astype(jnp.float32)
    p = p + mu * (centred_shift(p) - p)
    r, k, v, pw, pa, pg = jnp.split(p, RWKV_SPLITS, axis=-1)
    pw = pw.reshape(B, T, 2, DECAY_LORA)
    pa = pa.reshape(B, T, 2, ICLR_LORA)
    w_log = -jax.nn.softplus(-(w0 + jnp.einsum('btjl,jlc->btjc', jnp.tanh(pw), w2))) - 0.5
    decay = jnp.exp(-jnp.exp(w_log))
    iclr = jax.nn.sigmoid(a0 + jnp.einsum('btjl,jlc->btjc', pa, a2))
    k_dir = k[:, :, None] * (1.0 + (iclr - 1.0) * k_a)
    g = jax.nn.sigmoid(pg) @ g2

    def heads(t):
        return t.reshape(t.shape[:-1] + (RWKV_HEADS, RWKV_HEAD))
    kk = heads(k * k_k)
    kk = kk * lax.rsqrt(jnp.sum(kk * kk, axis=-1, keepdims=True) + 1e-12)
    return heads(r), heads(v), kk, g, heads(decay), heads(iclr), heads(k_dir)


def rwkv_scan(s0, r, w, k, v, kk, a, reverse):
    xs = tuple(jnp.moveaxis(t, 1, 0) for t in (r, w, k, v, kk, a))

    def step(S, inp):
        r_t, w_t, k_t, v_t, kk_t, a_t = inp
        sa = jnp.einsum('bhvk,bhk->bhv', S, -kk_t)
        S = (S * w_t[:, :, None, :] + sa[..., None] * (kk_t * a_t)[:, :, None, :]
             + v_t[..., None] * k_t[:, :, None, :])
        return S, jnp.einsum('bhvk,bhk->bhv', S, r_t)

    s_end, ys = lax.scan(step, s0, xs, reverse=reverse)
    return s_end, jnp.moveaxis(ys, 0, 1)


def rwkv_readout(y, prep, r_k, ln_w, ln_b):
    r, v, _, g, _, _, k_dir = prep
    B, T = y.shape[:2]
    mean = jnp.mean(y, axis=-1, keepdims=True)
    var = jnp.mean(jnp.square(y - mean), axis=-1, keepdims=True)
    yn = ((y - mean) * lax.rsqrt(var + GN_EPS)).reshape(B, T, RWKV_WIDTH) * ln_w + ln_b
    bonus = jnp.sum(r * jnp.sum(k_dir, axis=2) * r_k, axis=-1, keepdims=True) * v
    return (yn + bonus.reshape(B, T, RWKV_WIDTH)) * g


def rwkv_branch(p_ctx, p_lat, mu, w0, w2, a0, a2, g2, k_k, k_a, r_k, ln_w, ln_b, with_ctx):
    pc = rwkv_prepare(p_ctx, mu, w0, w2, a0, a2, g2, k_k, k_a)
    pl = rwkv_prepare(p_lat, mu, w0, w2, a0, a2, g2, k_k, k_a)
    rc, vc, kkc, _, dc, ac, kc = pc
    rl, vl, kkl, _, dl, al, kl = pl
    s_zero = jnp.zeros((p_lat.shape[0], RWKV_HEADS, RWKV_HEAD, RWKV_HEAD), jnp.float32)
    y_lat = jnp.zeros_like(rl)
    y_ctx = jnp.zeros_like(rc) if with_ctx else None
    for j, reverse in enumerate((False, True)):
        s_ctx, yc = rwkv_scan(s_zero, rc, dc[:, :, j], kc[:, :, j], vc, kkc, ac[:, :, j], reverse)
        _, yl = rwkv_scan(s_ctx, rl, dl[:, :, j], kl[:, :, j], vl, kkl, al[:, :, j], reverse)
        y_lat = y_lat + yl
        if with_ctx:
            y_ctx = y_ctx + yc
    out_lat = rwkv_readout(y_lat, pl, r_k, ln_w, ln_b)
    out_ctx = rwkv_readout(y_ctx, pc, r_k, ln_w, ln_b) if with_ctx else None
    return out_ctx, out_lat


def mla_keys(p, kv_norm, w_ukv, kn_nope, kn_rope, cos, sin):
    B, T, _ = p.shape
    ckv = rmsnorm(p[..., Q_LORA:Q_LORA + KV_LORA], kv_norm)
    k_rope = rmsnorm(p[..., Q_LORA + KV_LORA:], kn_rope)
    kv = (ckv @ w_ukv).reshape(B, T, MLA_HEADS, MLA_NOPE + MLA_V)
    k_nope = rmsnorm(kv[..., :MLA_NOPE], kn_nope)
    v = kv[..., MLA_NOPE:]
    if cos is not None:
        k_rope = apply_rope(k_rope, cos, sin)
    return k_nope, k_rope, v


def mla_queries(p, q_norm, w_uq, qn_nope, qn_rope, cos, sin):
    B, T, _ = p.shape
    cq = rmsnorm(p[..., :Q_LORA], q_norm)
    q = (cq @ w_uq).reshape(B, T, MLA_HEADS, MLA_NOPE + MLA_ROPE)
    q_nope = rmsnorm(q[..., :MLA_NOPE], qn_nope)
    q_rope = rmsnorm(q[..., MLA_NOPE:], qn_rope)
    if cos is not None:
        q_rope = apply_rope(q_rope, cos[:, None], sin[:, None])
    return q_nope, q_rope


def mla_attend(q_nope, q_rope, k_nope, k_rope, v):
    s = (jnp.einsum('bqhd,bkhd->bhqk', q_nope, k_nope)
         + jnp.einsum('bqhr,bkr->bhqk', q_rope, k_rope))
    pr = jax.nn.softmax(s.astype(jnp.float32) * MLA_SCALE, axis=-1).astype(v.dtype)
    return jnp.einsum('bhqk,bkhd->bqhd', pr, v)


def mla_branch(p_ctx, p_lat, cos, sin, q_norm, kv_norm, w_uq, w_ukv, qn_nope, kn_nope,
               qn_rope, kn_rope, with_ctx):
    B, T, _ = p_lat.shape
    kn_c, kr_c, v_c = mla_keys(p_ctx, kv_norm, w_ukv, kn_nope, kn_rope, None, None)
    kn_l, kr_l, v_l = mla_keys(p_lat, kv_norm, w_ukv, kn_nope, kn_rope, cos, sin)
    qn_l, qr_l = mla_queries(p_lat, q_norm, w_uq, qn_nope, qn_rope, cos, sin)
    kn = jnp.concatenate([kn_c, kn_l], axis=1)
    kr = jnp.concatenate([kr_c, kr_l], axis=1)
    v = jnp.concatenate([v_c, v_l], axis=1)
    nb = T // Q_BLOCK

    def to_blocks(t):
        return jnp.swapaxes(t.reshape((B, nb, Q_BLOCK) + t.shape[2:]), 0, 1)

    out = lax.map(lambda qs: mla_attend(qs[0], qs[1], kn, kr, v), (to_blocks(qn_l), to_blocks(qr_l)))
    out_lat = jnp.swapaxes(out, 0, 1).reshape(B, T, MLA_HEADS * MLA_V)
    out_ctx = None
    if with_ctx:
        qn_c, qr_c = mla_queries(p_ctx, q_norm, w_uq, qn_nope, qn_rope, None, None)
        out_ctx = mla_attend(qn_c, qr_c, kn_c, kr_c, v_c).reshape(B, p_ctx.shape[1], MLA_HEADS * MLA_V)
    return out_ctx, out_lat


def merge_branches(gate_logits, ys, w_branch, w_out):
    B, T, _ = gate_logits.shape
    gates = jax.nn.sigmoid(gate_logits.reshape(B, T, N_BRANCH, D_MODEL))
    y = jnp.stack([t.astype(gate_logits.dtype) for t in ys], axis=2)
    br = jnp.einsum('btjn,jnd->btjd', y, w_branch)
    return jnp.sum(gates * br, axis=2) @ w_out


def token_mixer(h_ctx, h_lat, cos, sin, with_ctx, w_in, ssm_p, rwkv_p, mla_p, w_branch, w_out):
    p_ctx = h_ctx @ w_in
    p_lat = h_lat @ w_in
    s_c, s_l = ssm_branch(p_ctx[..., :RWKV_OFF], p_lat[..., :RWKV_OFF], *ssm_p, with_ctx=with_ctx)
    r_c, r_l = rwkv_branch(p_ctx[..., RWKV_OFF:MLA_OFF], p_lat[..., RWKV_OFF:MLA_OFF], *rwkv_p,
                           with_ctx=with_ctx)
    m_c, m_l = mla_branch(p_ctx[..., MLA_OFF:GATE_OFF], p_lat[..., MLA_OFF:GATE_OFF], cos, sin,
                          *mla_p, with_ctx=with_ctx)
    out_lat = merge_branches(p_lat[..., GATE_OFF:], (s_l, r_l, m_l), w_branch, w_out)
    out_ctx = merge_branches(p_ctx[..., GATE_OFF:], (s_c, r_c, m_c), w_branch, w_out) if with_ctx else None
    return out_ctx, out_lat


def ec_moe(h, router_w, w1, w3, w2):
    B, T, _ = h.shape
    cap = EC_CAPACITY * T // N_EXPERTS
    aff = jax.nn.softmax((h @ router_w).astype(jnp.float32), axis=-1)
    gate, idx = lax.top_k(jnp.swapaxes(aff, 1, 2), cap)
    bidx = jnp.arange(B)[:, None, None]
    xs = h[bidx, idx]
    hid = jax.nn.silu(jnp.einsum('becd,edf->becf', xs, w1)) * jnp.einsum('becd,edf->becf', xs, w3)
    y = jnp.einsum('becf,efd->becd', hid, w2) * gate[..., None].astype(h.dtype)
    return jnp.zeros_like(h).at[bidx, idx].add(y)


def setup_inputs(seed: int = 0) -> dict:
    key = jax.random.key(seed)
    ks = iter(jax.random.split(key, 64))
    f32 = jnp.float32

    def nrm(shape, scale):
        return scale * jax.random.normal(next(ks), shape, f32)

    def gain(shape):
        return 1.0 + nrm(shape, 0.02)

    L, D = DEPTH, D_MODEL
    G, P, GC = SSM_GROUPS, SSM_STATE, SSM_GROUP
    W, H, N = RWKV_WIDTH, RWKV_HEADS, RWKV_HEAD
    E, F = N_EXPERTS, EXPERT_FF
    return {
        'x': nrm((BATCH, SEQ, D), 1.0),
        'c': nrm((BATCH, D), 1.0),
        'ctx': nrm((BATCH, CTX_LEN, D), 1.0),
        'c_ctx': nrm((D,), 1.0),
        'ada_w': nrm((L, D, N_MOD * D), 0.5 * D ** -0.5),
        'ada_b': nrm((L, N_MOD * D), 0.02),
        'norm1_g': gain((L, D)),
        'norm2_g': gain((L, D)),
        'w_in': nrm((L, D, N_IN), D ** -0.5),
        'ssm_lambda_re': -0.5 + nrm((L, 2, G, P), 0.01),
        'ssm_lambda_im': math.pi * jnp.arange(P, dtype=f32) + nrm((L, 2, G, P), 0.01),
        'ssm_log_dt': jax.random.uniform(next(ks), (L, 2, G), f32,
                                         math.log(SSM_DT_MIN), math.log(SSM_DT_MAX)),
        'ssm_b_re': nrm((L, G, P, GC), (2.0 * GC) ** -0.5),
        'ssm_b_im': nrm((L, G, P, GC), (2.0 * GC) ** -0.5),
        'ssm_c_re': nrm((L, 2, G, GC, P), (2.0 * P) ** -0.5),
        'ssm_c_im': nrm((L, 2, G, GC, P), (2.0 * P) ** -0.5),
        'ssm_d': nrm((L, SSM_WIDTH), 1.0),
        'ssm_glu_w': nrm((L, SSM_WIDTH, SSM_WIDTH), SSM_WIDTH ** -0.5),
        'ssm_glu_b': nrm((L, SSM_WIDTH), 0.02),
        'rwkv_mu': jax.random.uniform(next(ks), (L, RWKV_IN), f32, 0.0, 1.0),
        'rwkv_w0': jax.random.uniform(next(ks), (L, 2, W), f32, -6.0, 0.0),
        'rwkv_w2': nrm((L, 2, DECAY_LORA, W), 0.5 * DECAY_LORA ** -0.5),
        'rwkv_a0': nrm((L, 2, W), 0.1),
        'rwkv_a2': nrm((L, 2, ICLR_LORA, W), 0.5 * ICLR_LORA ** -0.5),
        'rwkv_g2': nrm((L, GATE_LORA, W), GATE_LORA ** -0.5),
        'rwkv_k_k': 0.85 + nrm((L, W), 0.02),
        'rwkv_k_a': 1.0 + nrm((L, W), 0.02),
        'rwkv_r_k': nrm((L, H, N), 0.1),
        'rwkv_ln_w': gain((L, W)),
        'rwkv_ln_b': nrm((L, W), 0.02),
        'mla_q_norm': gain((L, Q_LORA)),
        'mla_kv_norm': gain((L, KV_LORA)),
        'mla_w_uq': nrm((L, Q_LORA, MLA_HEADS * (MLA_NOPE + MLA_ROPE)), Q_LORA ** -0.5),
        'mla_w_ukv': nrm((L, KV_LORA, MLA_HEADS * (MLA_NOPE + MLA_V)), KV_LORA ** -0.5),
        'mla_qn_nope': gain((L, MLA_NOPE)),
        'mla_kn_nope': gain((L, MLA_NOPE)),
        'mla_qn_rope': gain((L, MLA_ROPE)),
        'mla_kn_rope': gain((L, MLA_ROPE)),
        'w_branch': nrm((L, N_BRANCH, BRANCH_WIDTH, D), BRANCH_WIDTH ** -0.5),
        'w_out': nrm((L, D, D), D ** -0.5),
        'router_w': nrm((L, D, E), D ** -0.5),
        'moe_w1': nrm((L, E, D, F), D ** -0.5),
        'moe_w3': nrm((L, E, D, F), D ** -0.5),
        'moe_w2': nrm((L, E, F, D), F ** -0.5),
    }


def reference(x, c, ctx, c_ctx, ada_w, ada_b, norm1_g, norm2_g, w_in,
              ssm_lambda_re, ssm_lambda_im, ssm_log_dt, ssm_b_re, ssm_b_im, ssm_c_re, ssm_c_im,
              ssm_d, ssm_glu_w, ssm_glu_b,
              rwkv_mu, rwkv_w0, rwkv_w2, rwkv_a0, rwkv_a2, rwkv_g2, rwkv_k_k, rwkv_k_a, rwkv_r_k,
              rwkv_ln_w, rwkv_ln_b,
              mla_q_norm, mla_kv_norm, mla_w_uq, mla_w_ukv, mla_qn_nope, mla_kn_nope,
              mla_qn_rope, mla_kn_rope,
              w_branch, w_out, router_w, moe_w1, moe_w3, moe_w2):
    B, T, _ = x.shape
    rows = T // GRID_W
    cos, sin = axial_rope(rows)
    silu_c = jax.nn.silu(c)
    silu_cc = jax.nn.silu(c_ctx)
    for l in range(DEPTH):
        with_ctx = l < DEPTH - 1
        mod_lat = (silu_c @ ada_w[l] + ada_b[l]).reshape(B, N_MOD, 1, D_MODEL)
        mod_ctx = (silu_cc @ ada_w[l] + ada_b[l]).reshape(N_MOD, D_MODEL)
        h_lat = modulate(rmsnorm(x, norm1_g[l]), mod_lat[:, 0], mod_lat[:, 1])
        h_ctx = modulate(rmsnorm(ctx, norm1_g[l]), mod_ctx[0], mod_ctx[1])
        ssm_p = (ssm_lambda_re[l], ssm_lambda_im[l], ssm_log_dt[l], ssm_b_re[l], ssm_b_im[l],
                 ssm_c_re[l], ssm_c_im[l], ssm_d[l], ssm_glu_w[l], ssm_glu_b[l])
        rwkv_p = (rwkv_mu[l], rwkv_w0[l], rwkv_w2[l], rwkv_a0[l], rwkv_a2[l], rwkv_g2[l],
                  rwkv_k_k[l], rwkv_k_a[l], rwkv_r_k[l], rwkv_ln_w[l], rwkv_ln_b[l])
        mla_p = (mla_q_norm[l], mla_kv_norm[l], mla_w_uq[l], mla_w_ukv[l], mla_qn_nope[l],
                 mla_kn_nope[l], mla_qn_rope[l], mla_kn_rope[l])
        mix_ctx, mix_lat = token_mixer(h_ctx, h_lat, cos, sin, with_ctx, w_in[l], ssm_p, rwkv_p,
                                       mla_p, w_branch[l], w_out[l])
        x = x + mod_lat[:, 2] * mix_lat
        h2 = modulate(rmsnorm(x, norm2_g[l]), mod_lat[:, 3], mod_lat[:, 4])
        x = x + mod_lat[:, 5] * ec_moe(h2, router_w[l], moe_w1[l], moe_w3[l], moe_w2[l])
        if with_ctx:
            ctx = ctx + mod_ctx[2] * mix_ctx
            h2c = modulate(rmsnorm(ctx, norm2_g[l]), mod_ctx[3], mod_ctx[4])
            ctx = ctx + mod_ctx[5] * ec_moe(h2c, router_w[l], moe_w1[l], moe_w3[l], moe_w2[l])
    return x
```

```cpp
#include <hip/hip_runtime.h>
#include <stdint.h>
#include <stdio.h>

#define LAS __attribute__((address_space(3)))
typedef unsigned short bf16_t;
typedef short bf16x8 __attribute__((ext_vector_type(8)));
typedef float f32x4 __attribute__((ext_vector_type(4)));
typedef float f32x2 __attribute__((ext_vector_type(2)));
typedef unsigned u32x4 __attribute__((ext_vector_type(4)));
typedef unsigned u32x2 __attribute__((ext_vector_type(2)));

constexpr int NB = 16, TL = 2048, TC = 256, DM = 1024, DEPTH = 4;
constexpr int NL = NB * TL;
constexpr int NC = NB * TC;
constexpr int NT = NL + NC;
constexpr int N_IN = 6176, N_INP = 6400;
constexpr int LDP = 5888;
constexpr int PC_MLA = 1920, PC_CKV = 2304, PC_KR = 2560, PC_GATE = 2592;
constexpr int NCHROW = NT / 16;
constexpr int NE = 16, FF = 1536, EROWS = 4608;
constexpr float NORM_EPS = 1e-6f, GN_EPS = 64e-5f;
constexpr float QSCALE = 0.10206207261596577f * 1.4426950408889634f;

constexpr size_t MiB = 1u << 20;
constexpr size_t WS_CTL = 0, CTL_BYTES = 1 * MiB;
constexpr size_t WS_MOD = 1 * MiB;
constexpr size_t WS_AFF = 3 * MiB;
constexpr size_t WS_SLOT = 6 * MiB;
constexpr size_t WS_IDX = 9 * MiB;
constexpr size_t WS_GATE = 10 * MiB;
constexpr size_t WS_A16 = 11 * MiB;
constexpr size_t WS_WIN = 12 * MiB;
constexpr size_t WS_WLORA = WS_WIN + 13107200;
constexpr size_t WS_WUQ = WS_WLORA + 1966080;
constexpr size_t WS_WUKV = WS_WUQ + 589824;
constexpr size_t WS_WGLU = WS_WUKV + 524288;
constexpr size_t WS_WBR = WS_WGLU + 524288;
constexpr size_t WS_WOUT = WS_WBR + 3145728;
static_assert(WS_WOUT + 2097152 <= 46 * MiB, "small weights");
constexpr size_t WS_GRW = 46 * MiB;
constexpr size_t WS_GV = 48 * MiB;
constexpr size_t WS_RBIAS = 49 * MiB;
constexpr size_t WS_H = 62 * MiB;
constexpr size_t WS_P = 134 * MiB;
constexpr size_t WS_UT = 548 * MiB;
constexpr size_t WS_E = 620 * MiB;
constexpr size_t WS_QRAW = 692 * MiB;
constexpr size_t WS_KVRAW = 746 * MiB;
constexpr size_t WS_Q = 818 * MiB;
constexpr size_t WS_K = 872 * MiB;
constexpr size_t WS_V = 926 * MiB;
constexpr size_t WS_RKVK = 962 * MiB;
constexpr size_t WS_LIN = 1106 * MiB;
constexpr size_t WS_LOUT = 1133 * MiB;
constexpr size_t WS_W1S = 1313 * MiB;
constexpr size_t WS_W3S = 1329 * MiB;
constexpr size_t WS_XB = 1361 * MiB;
constexpr size_t WS_END = 1433 * MiB;
constexpr size_t WS_YBR0 = WS_UT, WS_YBR1 = WS_UT + 36 * MiB;
constexpr size_t WS_YBR2 = WS_E;
constexpr size_t WS_YG = WS_E + 36 * MiB;
constexpr size_t WS_Y2 = WS_QRAW;
constexpr size_t WS_H8 = WS_Q;
constexpr size_t WS_WIN8 = WS_K;
#ifndef WIN_NB16
#define WIN_NB16 12
#endif
constexpr size_t WS_MERGED = WS_Q;
constexpr size_t WS_BR = WS_RKVK;
constexpr size_t WS_W13 = WS_P;
constexpr size_t WS_W2 = WS_P + 96 * MiB;
constexpr size_t WS_XS = WS_P + 144 * MiB;
constexpr size_t WS_HID = WS_P + 288 * MiB;
constexpr size_t WS_YBUF = WS_P + 504 * MiB;
constexpr size_t YBR_STRIDE = (size_t)NT * 512 * 2;
static_assert(WS_YBR1 - WS_YBR0 == 36 * MiB && WS_YBR2 - WS_YBR1 == 36 * MiB && 36 * MiB == YBR_STRIDE, "ybr stride");

constexpr int LDS_BYTES = 147456;
constexpr int NTHREADS = 512;

__device__ __forceinline__ float bflo(unsigned w) { return __uint_as_float(w << 16); }
__device__ __forceinline__ float bfhi(unsigned w) { return __uint_as_float(w & 0xffff0000u); }
__device__ __forceinline__ unsigned pk2(float lo, float hi) { unsigned r; asm volatile("v_cvt_pk_bf16_f32 %0, %1, %2" : "=v"(r) : "v"(lo), "v"(hi)); return r; }
__device__ __forceinline__ float sigmoidf_(float x) { return __builtin_amdgcn_rcpf(1.0f + __expf(-x)); }
__device__ __forceinline__ float siluf_(float x) { return x * __builtin_amdgcn_rcpf(1.0f + __expf(-x)); }
__device__ __forceinline__ float gelu_tanh(float x) { const float z = 0.7978845608f * (x + 0.044715f * x * x * x); const float t = 1.0f - 2.0f * __builtin_amdgcn_rcpf(__expf(2.0f * z) + 1.0f); return 0.5f * x * (1.0f + t); }
template <int CTRL> __device__ __forceinline__ float dppf(float x) { return __builtin_bit_cast(float, __builtin_amdgcn_update_dpp(0, __builtin_bit_cast(int, x), CTRL, 0xf, 0xf, true)); }
__device__ __forceinline__ float red8(float x) { x += dppf<0xB1>(x); x += dppf<0x4E>(x); x += dppf<0x141>(x); return x; }
__device__ __forceinline__ float red16(float x) { x = red8(x); x += dppf<0x140>(x); return x; }
__device__ __forceinline__ float max16(float x) { x = fmaxf(x, dppf<0xB1>(x)); x = fmaxf(x, dppf<0x4E>(x)); x = fmaxf(x, dppf<0x141>(x)); x = fmaxf(x, dppf<0x140>(x)); return x; }
__device__ __forceinline__ float red64(float x) { x = red16(x); x += __shfl_xor(x, 16); x += __shfl_xor(x, 32); return x; }
__device__ __forceinline__ unsigned pk4_fp8(float a, float b, float c, float d) { a = __builtin_amdgcn_fmed3f(a, -448.f, 448.f); b = __builtin_amdgcn_fmed3f(b, -448.f, 448.f); c = __builtin_amdgcn_fmed3f(c, -448.f, 448.f); d = __builtin_amdgcn_fmed3f(d, -448.f, 448.f);
    int p = __builtin_amdgcn_cvt_pk_fp8_f32(a, b, 0, false); p = __builtin_amdgcn_cvt_pk_fp8_f32(c, d, p, true); return (unsigned)p; }
constexpr float F8_SG = 16.f;
constexpr float F8_SW = 1024.f, F8_SX = 16.f, F8_SH = 8.f;
__device__ __forceinline__ void unpack8(const u32x4 w, float (&f)[8]) { f[0] = bflo(w.x); f[1] = bfhi(w.x); f[2] = bflo(w.y); f[3] = bfhi(w.y); f[4] = bflo(w.z); f[5] = bfhi(w.z); f[6] = bflo(w.w); f[7] = bfhi(w.w); }
__device__ __forceinline__ u32x4 pack8(const float (&f)[8]) { u32x4 w; w.x = pk2(f[0], f[1]); w.y = pk2(f[2], f[3]); w.z = pk2(f[4], f[5]); w.w = pk2(f[6], f[7]); return w; }

#define XB_TMO      128
#define XB_XCNT(j)  (256  + 64 * (j))
#define XB_XSUB(j)  (1280 + 64 * (j))
#define XB_XGEN(j)  (2304 + 64 * (j))
#define XB_TOP      3328
#define XB_TOPGEN   3392
#define XCD_BAR_WORDS 3456
#define XB_SPIN_CAP (1u << 18)
__device__ __forceinline__ unsigned xb_ld(unsigned* p)              { return __hip_atomic_load(p, __ATOMIC_RELAXED, __HIP_MEMORY_SCOPE_AGENT); }
__device__ __forceinline__ unsigned xb_add(unsigned* p, unsigned v) { return __hip_atomic_fetch_add(p, v, __ATOMIC_RELAXED, __HIP_MEMORY_SCOPE_AGENT); }
__device__ __forceinline__ unsigned xb_xcc_id() { return (unsigned)__builtin_amdgcn_s_getreg((3 << 11) | 20) & 0xFu; }
#define XB_SPIN(cond, bar) do { unsigned _sp = 0; while (cond) { __builtin_amdgcn_s_sleep(1); \
    if ((++_sp & 255u) == 0u) { if (xb_ld(&(bar)[XB_TMO])) break; if (_sp > XB_SPIN_CAP) { atomicAdd(&(bar)[XB_TMO], 1u); break; } } } } while (0)
struct XcdBarrier { unsigned* bar; unsigned x; volatile LAS unsigned* st; };
__device__ __forceinline__ XcdBarrier xcd_barrier_post(unsigned* bar, volatile LAS unsigned* st) {
    XcdBarrier b; b.bar = bar; b.x = xb_xcc_id(); b.st = st;
    if (threadIdx.x == 0) (void)xb_add(&bar[XB_XCNT(b.x)], 1u);
    return b;
}
__device__ __forceinline__ void xcd_barrier_complete(unsigned* bar, unsigned x, unsigned& nloc, unsigned& nx) {
    const unsigned G = gridDim.x * gridDim.y * gridDim.z;
    unsigned sum, cnt, mine, sp = 0u;
    for (;;) {
        sum = 0u; cnt = 0u; mine = 0u;
#pragma unroll
        for (unsigned j = 0; j < 16; ++j) { const unsigned c = xb_ld(&bar[XB_XCNT(j)]); sum += c; cnt += (c > 0u) ? 1u : 0u; mine = (j == x) ? c : mine; }
        if (sum == G) break;
        __builtin_amdgcn_s_sleep(1);
        if ((++sp & 255u) == 0u) { if (xb_ld(&bar[XB_TMO])) break; if (sp > XB_SPIN_CAP) { atomicAdd(&bar[XB_TMO], 1u); break; } }
    }
    nloc = mine > 0u ? mine : 1u; nx = cnt > 0u ? cnt : 1u;
}
__device__ __forceinline__ void xcd_barrier(const XcdBarrier& b) {
    asm volatile("s_waitcnt vmcnt(0)" ::: "memory");
    __syncthreads();
    if (threadIdx.x == 0) {
        unsigned* bar = b.bar;
        __builtin_amdgcn_s_waitcnt(0);
        unsigned nloc = b.st[0], nx = b.st[1];
        if (nloc == 0u) { xcd_barrier_complete(bar, b.x, nloc, nx); b.st[0] = nloc; b.st[1] = nx; }
        const unsigned old = xb_add(&bar[XB_XSUB(b.x)], 1u);
        const unsigned gen = old / nloc;
        if (old + 1u == (gen + 1u) * nloc) {
            __builtin_amdgcn_fence(__ATOMIC_RELEASE, "agent");
            asm volatile("s_waitcnt vmcnt(0)" ::: "memory");
            const unsigned og = xb_add(&bar[XB_TOP], 1u);
            const unsigned tg = og / nx;
            if (og + 1u == (tg + 1u) * nx) xb_add(&bar[XB_TOPGEN], 1u);
            else XB_SPIN(xb_ld(&bar[XB_TOPGEN]) == tg, bar);
            __builtin_amdgcn_fence(__ATOMIC_ACQUIRE, "agent");
            xb_add(&bar[XB_XGEN(b.x)], 1u);
            asm volatile("s_waitcnt vmcnt(0)" ::: "memory");
        } else {
            XB_SPIN(xb_ld(&bar[XB_XGEN(b.x)]) == gen, bar);
            __builtin_amdgcn_fence(__ATOMIC_ACQUIRE, "agent");
            asm volatile("s_waitcnt vmcnt(0)" ::: "memory");
        }
    }
    __syncthreads();
}

namespace pg8 {
constexpr int BM = 256, BK = 64, HALF = 128, HTB = HALF * BK * 2, STAGE_BYTES = 8 * HTB, NXCD = 8, WGM = 8;
__device__ __forceinline__ int lds_byte(int r, int c) { const int st = (r >> 4) * 2 + (c >> 5), rr = r & 15, cc = c & 31, ob = rr * 64 + cc * 2; return st * 1024 + (ob ^ (((ob >> 9) & 1) << 5)); }
__device__ __forceinline__ void stage_rc(int b, int& R, int& C) { const int st = b / 1024, sb = b % 1024, swz = sb ^ (((sb >> 9) & 1) << 5); R = (st >> 1) * 16 + swz / 64; C = (st & 1) * 32 + (swz % 64) / 2; }
__device__ __forceinline__ int perm32(int rho) { const int n = rho >> 4, i = rho & 15; return 8 * (i >> 2) + 4 * n + (i & 3); }
struct Unit { int pm, pn, g; };
struct Gemm { const bf16_t* A; const bf16_t* Bt; int lda, ldb, K; size_t gsA, gsB; };

struct GroupOrder {
    int nM, nN, per, nwg, G, c;
    __device__ void init(int nM_, int nN_, int nG, int G_, int c_, int rot = 0) { nM = nM_; nN = nN_; per = nM * nN; nwg = per * nG; G = G_; c = (c_ + G_ - (rot % G_)) % G_; }
    __device__ bool next(int i, Unit& u) const {
        const long L = (long)i * G + c; if (L >= nwg) return false;
        int wgid = (int)L; { const int q = nwg / NXCD, r = nwg % NXCD, xcd = wgid % NXCD, off = wgid / NXCD; wgid = (xcd < r ? xcd * (q + 1) : r * (q + 1) + (xcd - r) * q) + off; }
        u.g = wgid / per; const int w = wgid - u.g * per;
        const int nig = WGM * nN, gid = w / nig, fm = gid * WGM, gsz = (nM - fm) < WGM ? (nM - fm) : WGM;
        u.pm = fm + ((w % nig) % gsz); u.pn = (w % nig) / gsz; return true;
    }
};
struct MergeOrder {
    int nM, nN, ntile, G, c;
    __device__ void init(int nM_, int nN_, int G_, int c_) { nM = nM_; nN = nN_; ntile = nM * nN; G = G_; c = c_; }
    __device__ bool next(int i, Unit& u) const {
        const int t = (i / 3) * G + c; if (t >= ntile) return false;
        u.g = i % 3; u.pm = t / nN; u.pn = t % nN; return true;
    }
};

typedef int v8i32 __attribute__((ext_vector_type(8)));
__device__ __forceinline__ v8i32 cat8(const bf16x8& a, const bf16x8& b) { const u32x4 x = __builtin_bit_cast(u32x4, a), y = __builtin_bit_cast(u32x4, b); return (v8i32){(int)x.x, (int)x.y, (int)x.z, (int)x.w, (int)y.x, (int)y.y, (int)y.z, (int)y.w}; }
template <class Epi, class Sched, bool FP8 = false>
__device__ __forceinline__ void gemm_phase(LAS unsigned char* lds, const int tid, const Gemm g, const Sched& S, const Epi& E) {
    const int wid = __builtin_amdgcn_readfirstlane(tid >> 6), lane = tid & 63, wr = wid >> 2, wc = wid & 3, fr = lane & 15, fq = lane >> 4;
    constexpr int EB = FP8 ? 1 : 2;
    const int K = g.K, nt = (K * EB) / (BK * 2);
    unsigned voffA, voffB;
    { int R, C; stage_rc(tid * 16, R, C); const int Rb = Epi::PERM ? ((R & ~31) + perm32(R & 31)) : R; voffA = (unsigned)(R * g.lda * EB + C * 2); voffB = (unsigned)(Rb * g.ldb * EB + C * 2); }
    const size_t r64voffA = (size_t)64 * g.lda * EB, r64voffB = (size_t)64 * g.ldb * EB;
    const size_t kstep = (size_t)(BK * 2);
    const size_t hstepA = (size_t)HALF * g.lda * EB, hstepB = (size_t)HALF * g.ldb * EB;
    const size_t tstepA = 2 * hstepA, tstepB = 2 * hstepB;
    const unsigned ldsw = (unsigned)wid * 1024u;
    const int aoff = lds_byte(wr * 64 + fr, fq * 8), boff = lds_byte(wc * 32 + fr, fq * 8);
#define PG8_SA(b, h) (((b) * 2 + (h)) * HTB)
#define PG8_SB(b, h) ((4 + (b) * 2 + (h)) * HTB)
#define PG8_STAGE(bufoff, gbase, voff) do { _Pragma("unroll") for (int _i = 0; _i < 2; ++_i) \
        __builtin_amdgcn_global_load_lds((const unsigned*)((const char*)(gbase) + (size_t)_i * r64##voff + (voff)), (LAS unsigned*)(lds + (bufoff) + ldsw + _i * 8192), 16, 0, 0); } while (0)
#define PG8_LD8(dst, off) do { typedef int v4i32_ __attribute__((ext_vector_type(4))); const v4i32_ lo_ = *(const LAS v4i32_*)(lds + (off)), hi_ = *(const LAS v4i32_*)(lds + (off) + 1024); (dst) = __builtin_shufflevector(lo_, hi_, 0, 1, 2, 3, 4, 5, 6, 7); } while (0)
#define PG8_LDA(dst, b, h) do { if constexpr (FP8) { _Pragma("unroll") for (int m = 0; m < 4; ++m) PG8_LD8(dst##8[m], PG8_SA(b, h) + aoff + m * 2048); } \
      else { _Pragma("unroll") for (int m = 0; m < 4; ++m) _Pragma("unroll") for (int k = 0; k < 2; ++k) dst[m][k] = *(const LAS bf16x8*)(lds + PG8_SA(b, h) + aoff + m * 2048 + k * 1024); } } while (0)
#define PG8_LDB(dst, b, h) do { if constexpr (FP8) { _Pragma("unroll") for (int n = 0; n < 2; ++n) PG8_LD8(dst##8[n], PG8_SB(b, h) + boff + n * 2048); } \
      else { _Pragma("unroll") for (int n = 0; n < 2; ++n) _Pragma("unroll") for (int k = 0; k < 2; ++k) dst[n][k] = *(const LAS bf16x8*)(lds + PG8_SB(b, h) + boff + n * 2048 + k * 1024); } } while (0)
#define PG8_MMA(ai, bj, At, Bt) do { __builtin_amdgcn_s_setprio(1); if constexpr (FP8) { _Pragma("unroll") for (int m = 0; m < 4; ++m) _Pragma("unroll") for (int n = 0; n < 2; ++n) \
        asm("v_mfma_scale_f32_16x16x128_f8f6f4 %0, %1, %2, %0, %3, %3 op_sel_hi:[0,0,0]" : "+v"(acc[ai][bj][m][n]) : "v"(Bt##8[n]), "v"(At##8[m]), "v"(f8scale));     } \
      else { _Pragma("unroll") for (int m = 0; m < 4; ++m) _Pragma("unroll") for (int n = 0; n < 2; ++n) _Pragma("unroll") for (int k = 0; k < 2; ++k) \
        acc[ai][bj][m][n] = __builtin_amdgcn_mfma_f32_16x16x32_bf16(Bt[n][k], At[m][k], acc[ai][bj][m][n], 0, 0, 0); } __builtin_amdgcn_s_setprio(0); } while (0)
#define PG8_WAIT_V(n) asm volatile("s_waitcnt vmcnt(" #n ")" ::: "memory")
#define PG8_WAIT_L(n) asm volatile("s_waitcnt lgkmcnt(" #n ")" ::: "memory")
#define PG8_BAR __builtin_amdgcn_s_barrier()
#define PG8_SCHED __builtin_amdgcn_sched_barrier(0)
    Unit cur, nxt; int ui = 0;
    if (!S.next(0, cur)) return;
    f32x4 acc[2][2][4][2];
#pragma unroll
    for (int a = 0; a < 2; ++a)
#pragma unroll
        for (int b = 0; b < 2; ++b)
#pragma unroll
            for (int m = 0; m < 4; ++m)
#pragma unroll
                for (int n = 0; n < 2; ++n) acc[a][b][m][n] = (f32x4){0.f, 0.f, 0.f, 0.f};
    bf16x8 At[4][2], B0[2][2], B1[2][2];
    v8i32 At8[4], B08[2], B18[2];
    const int f8scale = 0x7f7f7f7f;
    const char* cA = (const char*)g.A + (size_t)cur.g * g.gsA + (size_t)cur.pm * tstepA; const char* cB = (const char*)g.Bt + (size_t)cur.g * g.gsB + (size_t)cur.pn * tstepB;
    PG8_STAGE(PG8_SB(0, 0), cB, voffB); PG8_STAGE(PG8_SA(0, 0), cA, voffA); PG8_STAGE(PG8_SB(0, 1), cB + hstepB, voffB); PG8_STAGE(PG8_SA(0, 1), cA + hstepA, voffA);
    if (wr == 1) PG8_BAR;
    PG8_WAIT_V(4); PG8_BAR;
    PG8_STAGE(PG8_SB(1, 0), cB + kstep, voffB); PG8_STAGE(PG8_SA(1, 0), cA + kstep, voffA); PG8_STAGE(PG8_SB(1, 1), cB + hstepB + kstep, voffB);
    PG8_WAIT_V(6); PG8_BAR;
    for (;;) {
        const bool has_next = S.next(ui + 1, nxt);
        const char* nA = has_next ? (const char*)g.A + (size_t)nxt.g * g.gsA + (size_t)nxt.pm * tstepA : cA; const char* nB = has_next ? (const char*)g.Bt + (size_t)nxt.g * g.gsB + (size_t)nxt.pn * tstepB : cB;
#pragma nounroll
        for (int t = 0; t < nt; t += 2) {
            const bool last = (t == nt - 2);
            const char* a1 = cA + (size_t)(t + 1) * kstep;
            const char* a2 = last ? nA : cA + (size_t)(t + 2) * kstep; const char* b2 = last ? nB : cB + (size_t)(t + 2) * kstep;
            const char* a3 = a2 + kstep; const char* b3 = b2 + kstep;
            PG8_LDB(B0, 0, 0); PG8_SCHED; PG8_LDA(At, 0, 0); PG8_STAGE(PG8_SA(1, 1), a1 + hstepA, voffA);
            PG8_WAIT_L(8); PG8_BAR; PG8_WAIT_L(0); PG8_MMA(0, 0, At, B0); PG8_BAR; PG8_SCHED;
            PG8_LDB(B1, 0, 1); PG8_STAGE(PG8_SB(0, 0), b2, voffB);
            PG8_BAR; PG8_WAIT_L(0); PG8_MMA(0, 1, At, B1); PG8_BAR;
            PG8_LDA(At, 0, 1); PG8_STAGE(PG8_SA(0, 0), a2, voffA);
            PG8_BAR; PG8_WAIT_L(0); PG8_MMA(1, 0, At, B0); PG8_BAR; PG8_SCHED;
            PG8_STAGE(PG8_SB(0, 1), b2 + hstepB, voffB);
            PG8_WAIT_V(6); PG8_BAR; PG8_MMA(1, 1, At, B1); PG8_BAR;
            PG8_LDB(B0, 1, 0); PG8_SCHED; PG8_LDA(At, 1, 0); PG8_STAGE(PG8_SA(0, 1), a2 + hstepA, voffA);
            PG8_WAIT_L(8); PG8_BAR; PG8_WAIT_L(0); PG8_MMA(0, 0, At, B0); PG8_BAR; PG8_SCHED;
            PG8_LDB(B1, 1, 1); PG8_STAGE(PG8_SB(1, 0), b3, voffB);
            PG8_BAR; PG8_WAIT_L(0); PG8_MMA(0, 1, At, B1); PG8_BAR;
            PG8_LDA(At, 1, 1); PG8_STAGE(PG8_SA(1, 0), a3, voffA);
            PG8_BAR; PG8_WAIT_L(0); PG8_MMA(1, 0, At, B0); PG8_BAR; PG8_SCHED;
            PG8_STAGE(PG8_SB(1, 1), b3 + hstepB, voffB);
            PG8_WAIT_V(6); PG8_BAR; PG8_MMA(1, 1, At, B1); PG8_BAR;
        }
        E(acc, cur, wr, wc, fr, fq);
        if (!has_next) break;
#pragma unroll
        for (int a = 0; a < 2; ++a)
#pragma unroll
            for (int b = 0; b < 2; ++b)
#pragma unroll
                for (int m = 0; m < 4; ++m)
#pragma unroll
                    for (int n = 0; n < 2; ++n) acc[a][b][m][n] = (f32x4){0.f, 0.f, 0.f, 0.f};
        cur = nxt; cA = nA; cB = nB; ++ui;
    }
    PG8_WAIT_V(0);
    if (wr == 0) PG8_BAR;
    PG8_BAR;
#undef PG8_SA
#undef PG8_SB
#undef PG8_STAGE
#undef PG8_LD8
#undef PG8_LDA
#undef PG8_LDB
#undef PG8_MMA
#undef PG8_WAIT_V
#undef PG8_WAIT_L
#undef PG8_BAR
#undef PG8_SCHED
}
}
using pg8::Unit;
typedef f32x4 Acc[2][2][4][2];
#define EPI_ROWS(...) _Pragma("unroll") for (int ai = 0; ai < 2; ++ai) _Pragma("unroll") for (int m = 0; m < 4; ++m) { const int row = row0 + ai * 128 + m * 16; __VA_ARGS__ }

__device__ __forceinline__ u32x4 pack_acc8(const f32x4& a, const f32x4& b) { u32x4 w; w.x = pk2(a[0], a[1]); w.y = pk2(a[2], a[3]); w.z = pk2(b[0], b[1]); w.w = pk2(b[2], b[3]); return w; }

struct EpiWin { static constexpr bool PERM = true; bf16_t* P; bf16_t* UT; int pn0; float s;
    __device__ __forceinline__ void operator()(const Acc& acc, const Unit& u, int wr, int wc, int fr, int fq) const {
        const int row0 = u.pm * 256 + wr * 64 + fr;
        EPI_ROWS(
_Pragma("unroll")
            for (int bj = 0; bj < 2; ++bj) { const int col0 = (u.pn + pn0) * 256 + bj * 128 + wc * 32 + 8 * fq;
                if (col0 >= 512 + PC_GATE) { const f32x4 a0 = acc[ai][bj][m][0] * (s * F8_SG), a1 = acc[ai][bj][m][1] * (s * F8_SG);
                    *(u32x2*)((unsigned char*)(P + (size_t)row * LDP + PC_GATE) + (col0 - 512 - PC_GATE)) = (u32x2){pk4_fp8(a0[0], a0[1], a0[2], a0[3]), pk4_fp8(a1[0], a1[1], a1[2], a1[3])}; }
                else { const u32x4 w = pack_acc8(acc[ai][bj][m][0] * s, acc[ai][bj][m][1] * s);
                    bf16_t* dst = (u.pn + pn0 < 2) ? UT + ((size_t)(col0 >> 4) * NCHROW + (row >> 4)) * 512 + (row & 15) * 16 + (col0 & 15) : P + (size_t)row * LDP + (col0 - 512);
                    *(u32x4*)dst = w; } } )
    } };
struct EpiBf16 { static constexpr bool PERM = true; bf16_t* O; int ldc; size_t gstride;
    __device__ __forceinline__ void operator()(const Acc& acc, const Unit& u, int wr, int wc, int fr, int fq) const {
        const int row0 = u.pm * 256 + wr * 64 + fr;
        EPI_ROWS(
_Pragma("unroll")
            for (int bj = 0; bj < 2; ++bj) { const int col0 = u.pn * 256 + bj * 128 + wc * 32 + 8 * fq; *(u32x4*)(O + (size_t)u.g * gstride + (size_t)row * ldc + col0) = pack_acc8(acc[ai][bj][m][0], acc[ai][bj][m][1]); } )
    } };
struct EpiSsmE { static constexpr bool PERM = false; float* Eo;
    __device__ __forceinline__ void operator()(const Acc& acc, const Unit& u, int wr, int wc, int fr, int fq) const {
        const int row0 = u.pm * 256 + wr * 64 + fr; float* base = Eo + (size_t)u.g * NCHROW * 256;
        EPI_ROWS(
_Pragma("unroll")
            for (int bj = 0; bj < 2; ++bj)
_Pragma("unroll")
                for (int n = 0; n < 2; ++n) *(f32x4*)(base + (size_t)row * 256 + bj * 128 + wc * 32 + n * 16 + 4 * fq) = acc[ai][bj][m][n]; )
    } };
struct EpiLora { static constexpr bool PERM = true; bf16_t* O; const float* w0; const float* a0;
    __device__ __forceinline__ void operator()(const Acc& acc, const Unit& u, int wr, int wc, int fr, int fq) const {
        const int row0 = u.pm * 256 + wr * 64 + fr; const int reg = u.pn >> 1, cb = u.g * 512 + (u.pn & 1) * 256;
        const float scl = reg == 0 ? 0.6065306597f : 1.0f; const float* bsrc = (reg == 0 ? w0 : a0) + cb; bf16_t* ob = O + reg * 1024 + cb;
#pragma unroll
        for (int bj = 0; bj < 2; ++bj) { const int cl = bj * 128 + wc * 32 + 8 * fq;
            const f32x4 b0 = *(const f32x4*)(bsrc + cl), b1 = *(const f32x4*)(bsrc + cl + 4);
            EPI_ROWS( const f32x4 x0 = acc[ai][bj][m][0] + b0; const f32x4 x1 = acc[ai][bj][m][1] + b1; float v[8];
_Pragma("unroll")
                for (int j = 0; j < 4; ++j) { v[j] = scl * sigmoidf_(x0[j]); v[4 + j] = scl * sigmoidf_(x1[j]); }
                *(u32x4*)(ob + (size_t)row * 2560 + cl) = pack8(v); )
        }
    } };
struct EpiSsmY { static constexpr bool PERM = true; bf16_t* YG;
    __device__ __forceinline__ void operator()(const Acc& acc, const Unit& u, int wr, int wc, int fr, int fq) const {
        const int row0 = u.pm * 256 + wr * 64 + fr;
        EPI_ROWS(
_Pragma("unroll")
            for (int bj = 0; bj < 2; ++bj) { const int n0 = bj * 128 + wc * 32 + 8 * fq; const int tok = row * 16 + (n0 >> 4); float v[8];
_Pragma("unroll")
                for (int j = 0; j < 8; ++j) v[j] = gelu_tanh(j < 4 ? acc[ai][bj][m][0][j & 3] : acc[ai][bj][m][1][j & 3]);
                *(u32x4*)(YG + (size_t)tok * 512 + u.g * 16 + (n0 & 15)) = pack8(v); } )
    } };
struct EpiGlu { static constexpr bool PERM = true; const bf16_t* YG; const float* bias; bf16_t* O;
    __device__ __forceinline__ void operator()(const Acc& acc, const Unit& u, int wr, int wc, int fr, int fq) const {
        const int row0 = u.pm * 256 + wr * 64 + fr;
_Pragma("unroll")
        for (int bj = 0; bj < 2; ++bj) { const int col0 = u.pn * 256 + bj * 128 + wc * 32 + 8 * fq; float b[8];
_Pragma("unroll")
            for (int j = 0; j < 8; ++j) b[j] = bias[col0 + j];
            EPI_ROWS( float y[8], v[8]; unpack8(*(const u32x4*)(YG + (size_t)row * 512 + col0), y);
_Pragma("unroll")
                for (int j = 0; j < 8; ++j) v[j] = y[j] * sigmoidf_((j < 4 ? acc[ai][bj][m][0][j & 3] : acc[ai][bj][m][1][j & 3]) + b[j]);
                *(u32x4*)(O + (size_t)row * 512 + col0) = pack8(v); )
        }
    } };
struct EpiWout { static constexpr bool PERM = true; bf16_t* XB; const float* mod;
    __device__ __forceinline__ void operator()(const Acc& acc, const Unit& u, int wr, int wc, int fr, int fq) const {
        const int row0 = u.pm * 256 + wr * 64 + fr; const int mrow = u.pm < NL / 256 ? (u.pm >> 3) : 16; const float* gv = mod + (size_t)mrow * 6144 + 2 * 1024;
_Pragma("unroll")
        for (int bj = 0; bj < 2; ++bj) { const int col0 = u.pn * 256 + bj * 128 + wc * 32 + 8 * fq; const f32x4 g0 = *(const f32x4*)(gv + col0), g1 = *(const f32x4*)(gv + col0 + 4);
            EPI_ROWS( bf16_t* xp = XB + (size_t)row * 1024 + col0; float xv[8]; unpack8(*(const u32x4*)xp, xv); const f32x4 a0 = acc[ai][bj][m][0] * g0, a1 = acc[ai][bj][m][1] * g1;
_Pragma("unroll")
                for (int j = 0; j < 4; ++j) { xv[j] += a0[j]; xv[4 + j] += a1[j]; }
                *(u32x4*)xp = pack8(xv); ) }
    } };
struct EpiMoe1 { static constexpr bool PERM = true; unsigned char* HID;
    __device__ __forceinline__ void operator()(const Acc& acc, const Unit& u, int wr, int wc, int fr, int fq) const {
        const int row0 = u.pm * 256 + wr * 64 + fr; unsigned char* base = HID + (size_t)u.g * EROWS * FF; constexpr float S1 = 1.0f / (F8_SX * F8_SW);
        EPI_ROWS( float v[8];
_Pragma("unroll")
            for (int j = 0; j < 8; ++j) { const float a = (j < 4 ? acc[ai][0][m][0][j & 3] : acc[ai][0][m][1][j & 3]) * S1; const float b = (j < 4 ? acc[ai][1][m][0][j & 3] : acc[ai][1][m][1][j & 3]) * S1; v[j] = siluf_(a) * b * F8_SH; }
            *(u32x2*)(base + (size_t)row * FF + u.pn * 128 + wc * 32 + 8 * fq) = (u32x2){pk4_fp8(v[0], v[1], v[2], v[3]), pk4_fp8(v[4], v[5], v[6], v[7])}; __builtin_amdgcn_sched_barrier(0); )
    } };
struct EpiMoe2 { static constexpr bool PERM = true; bf16_t* Y; const float* gate;
    __device__ __forceinline__ void operator()(const Acc& acc, const Unit& u, int wr, int wc, int fr, int fq) const {
        const int row0 = u.pm * 256 + wr * 64 + fr; bf16_t* base = Y + (size_t)u.g * EROWS * 1024; const float* gt = gate + (size_t)u.g * EROWS;
        EPI_ROWS( const float gv = gt[row] * (1.0f / (F8_SH * F8_SW));
_Pragma("unroll")
            for (int bj = 0; bj < 2; ++bj) { const int col0 = u.pn * 256 + bj * 128 + wc * 32 + 8 * fq; float v[8];
_Pragma("unroll")
                for (int j = 0; j < 8; ++j) v[j] = gv * (j < 4 ? acc[ai][bj][m][0][j & 3] : acc[ai][bj][m][1][j & 3]);
                *(u32x4*)(base + (size_t)row * 1024 + col0) = pack8(v); } )
    } };

struct Args { const float* in[44]; float* out; unsigned char* ws; int ph_lo, ph_hi; unsigned bmask; int pad; };
struct Ctx {
    const __attribute__((address_space(4))) Args* A; float* out; unsigned char* ws; LAS unsigned char* lds; int tid, lane, wave, G, bid;
};
#define GAS __attribute__((address_space(1)))
#define WSP(T, off) ((T*)(C.ws + (off)))
#define CIN(i) ({ const GAS float* p__ = (const GAS float*)C.A->in[i]; asm volatile("" : "+s"(p__)); (const float*)p__; })

__device__ __forceinline__ void phase_ada(const Ctx& C) {
    LAS float* sck = (LAS float*)C.lds;
    LAS float* red = (LAS float*)(C.lds + 81920);
    const float* c = CIN(1); const float* cc = CIN(3); const float* ada_w = CIN(4); const float* ada_b = CIN(5);
    float* MOD = WSP(float, WS_MOD);
    for (int idx = C.tid; idx < 17 * 1024; idx += NTHREADS) { const int m = idx >> 10, k = idx & 1023; const float v = m < 16 ? c[m * 1024 + k] : cc[k]; sck[k * 20 + m] = siluf_(v); }
    __syncthreads();
    const int cl = C.lane & 31, kh = C.lane >> 5;
    for (int u = C.bid; u < 4 * 192; u += C.G) {
        const int l = u / 192, n0 = (u % 192) * 32;
        float acc[17];
#pragma unroll
        for (int m = 0; m < 17; ++m) acc[m] = 0.f;
        const int kb = C.wave * 128 + kh * 64;
        const float* wp = ada_w + ((size_t)l * 1024 + kb) * 6144 + n0 + cl;
#pragma unroll 1
        for (int k0 = 0; k0 < 64; k0 += 16) { float a[16];
#pragma unroll
            for (int q = 0; q < 16; ++q) a[q] = wp[(size_t)(k0 + q) * 6144];
#pragma unroll
            for (int q = 0; q < 16; ++q) { const LAS float* s = sck + (kb + k0 + q) * 20;
                const f32x4 s0 = *(const LAS f32x4*)s, s1 = *(const LAS f32x4*)(s + 4), s2 = *(const LAS f32x4*)(s + 8), s3 = *(const LAS f32x4*)(s + 12); const float s4 = s[16];
#pragma unroll
                for (int j = 0; j < 4; ++j) { acc[j] += s0[j] * a[q]; acc[4 + j] += s1[j] * a[q]; acc[8 + j] += s2[j] * a[q]; acc[12 + j] += s3[j] * a[q]; }
                acc[16] += s4 * a[q]; } }
#pragma unroll
        for (int m = 0; m < 17; ++m) { acc[m] += __shfl_xor(acc[m], 32); if (kh == 0) red[(C.wave * 17 + m) * 32 + cl] = acc[m]; }
        __syncthreads();
        for (int o = C.tid; o < 17 * 32; o += NTHREADS) { const int m = o >> 5, n = o & 31; float s = ada_b[l * 6144 + n0 + n];
#pragma unroll
            for (int w = 0; w < 8; ++w) s += red[(w * 17 + m) * 32 + n];
            MOD[((size_t)l * 17 + m) * 6144 + n0 + n] = s; }
        __syncthreads();
    }
}

__device__ __forceinline__ void conv_tile(const Ctx& C, const float* src, int src_ld, bf16_t* dst, int dst_ld, int n_valid, const float* kgain) {
    LAS float* tile = (LAS float*)C.lds + C.wave * (64 * 65);
    const int r4 = C.lane >> 4, c4 = (C.lane & 15) * 4;
    f32x4 v[16];
#pragma unroll
    for (int i = 0; i < 16; ++i) { v[i] = (f32x4){0.f, 0.f, 0.f, 0.f}; if (src && c4 < n_valid) v[i] = *(const f32x4*)(src + (size_t)(i * 4 + r4) * src_ld + c4); }
    if (kgain) {
#pragma unroll
        for (int i = 0; i < 16; ++i) v[i] *= kgain[i * 4 + r4]; }
#pragma unroll
    for (int i = 0; i < 16; ++i) { LAS float* t = tile + (i * 4 + r4) * 65 + c4; t[0] = v[i][0]; t[1] = v[i][1]; t[2] = v[i][2]; t[3] = v[i][3]; }
    asm volatile("s_waitcnt lgkmcnt(0)" ::: "memory");
    const int nr = C.lane >> 3, ks = (C.lane & 7) * 8;
#pragma unroll
    for (int i = 0; i < 8; ++i) { const int n = i * 8 + nr; float o[8];
#pragma unroll
        for (int j = 0; j < 8; ++j) o[j] = tile[(ks + j) * 65 + n];
        *(u32x4*)(dst + (size_t)n * dst_ld + ks) = pack8(o); }
    asm volatile("s_waitcnt lgkmcnt(0)" ::: "memory");
}

__device__ __forceinline__ void conv_tile_fp8(const Ctx& C, const float* src, int src_ld, unsigned char* dst, int dst_ld, int n_valid = 64) {
    LAS float* tile = (LAS float*)C.lds + C.wave * (64 * 65);
    const int r4 = C.lane >> 4, c4 = (C.lane & 15) * 4;
    f32x4 v[16];
#pragma unroll
    for (int i = 0; i < 16; ++i) { v[i] = (f32x4){0.f, 0.f, 0.f, 0.f}; if (src && c4 < n_valid) v[i] = *(const f32x4*)(src + (size_t)(i * 4 + r4) * src_ld + c4); }
#pragma unroll
    for (int i = 0; i < 16; ++i) { LAS float* t = tile + (i * 4 + r4) * 65 + c4; t[0] = v[i][0] * F8_SW; t[1] = v[i][1] * F8_SW; t[2] = v[i][2] * F8_SW; t[3] = v[i][3] * F8_SW; }
    asm volatile("s_waitcnt lgkmcnt(0)" ::: "memory");
    const int nr = C.lane >> 3, ks = (C.lane & 7) * 8;
#pragma unroll
    for (int i = 0; i < 8; ++i) { const int n = i * 8 + nr; float o[8];
#pragma unroll
        for (int j = 0; j < 8; ++j) o[j] = tile[(ks + j) * 65 + n];
        *(u32x2*)(dst + (size_t)n * dst_ld + ks) = (u32x2){pk4_fp8(o[0], o[1], o[2], o[3]), pk4_fp8(o[4], o[5], o[6], o[7])}; }
    asm volatile("s_waitcnt lgkmcnt(0)" ::: "memory");
}

__device__ __forceinline__ void phase_conv_small(const Ctx& C, int l) {
    for (int t = C.bid * 8 + C.wave; t < 2680; t += C.G * 8) {
        if (t < 1600) { const int nt = t >> 4, kt = t & 15; const float* w = CIN(8) + (size_t)l * 1024 * N_IN;
            if (nt < WIN_NB16 * 4) conv_tile(C, w + (size_t)kt * 64 * N_IN + nt * 64, N_IN, WSP(bf16_t, WS_WIN) + (size_t)nt * 64 * 1024 + kt * 64, 1024, 64, nullptr);
            else conv_tile_fp8(C, nt <= 96 ? w + (size_t)kt * 64 * N_IN + nt * 64 : nullptr, N_IN, WSP(unsigned char, WS_WIN8) + (size_t)nt * 64 * 1024 + kt * 64, 1024, nt < 96 ? 64 : 32); }
        else if (t < 1840) { const int q = t - 1600;
            if (q < 64) { const int j = q >> 5, r = q & 31, nt = r >> 1, kt = r & 1; const int n0 = nt * 64; const float* src = nullptr;
                if (n0 < 512) { if (kt == 0) src = CIN(21) + ((size_t)l * 2 + j) * 64 * 512 + n0; } else { if (kt == 1) src = CIN(23) + ((size_t)l * 2 + j) * 64 * 512 + (n0 - 512); }
                conv_tile(C, src, 512, WSP(bf16_t, WS_WLORA) + ((size_t)j * 1024 + n0) * 128 + kt * 64, 128, 64, nullptr); }
            else if (q < 80) { const int r = q - 64, nt = r >> 1, kt = r & 1;
                conv_tile(C, CIN(24) + ((size_t)l * 128 + kt * 64) * 512 + nt * 64, 512, WSP(bf16_t, WS_WLORA) + (size_t)2 * 1024 * 128 + (size_t)nt * 64 * 128 + kt * 64, 128, 64, nullptr); } }
        else if (t < 1912) { const int q = t - 1840, nt = q / 6, kt = q % 6;
            conv_tile(C, CIN(32) + ((size_t)l * 384 + kt * 64) * 768 + nt * 64, 768, WSP(bf16_t, WS_WUQ) + (size_t)nt * 64 * 384 + kt * 64, 384, 64, CIN(30) + l * 384 + kt * 64); }
        else if (t < 1976) { const int q = t - 1912, nt = q >> 2, kt = q & 3;
            conv_tile(C, CIN(33) + ((size_t)l * 256 + kt * 64) * 1024 + nt * 64, 1024, WSP(bf16_t, WS_WUKV) + (size_t)nt * 64 * 256 + kt * 64, 256, 64, CIN(31) + l * 256 + kt * 64); }
        else if (t < 2040) { const int q = t - 1976, nt = q >> 3, kt = q & 7;
            conv_tile(C, CIN(17) + ((size_t)l * 512 + kt * 64) * 512 + nt * 64, 512, WSP(bf16_t, WS_WGLU) + (size_t)nt * 64 * 512 + kt * 64, 512, 64, nullptr); }
        else if (t < 2424) { const int q = t - 2040, j = q >> 7, r = q & 127, nt = r >> 3, kt = r & 7;
            conv_tile(C, CIN(38) + (((size_t)l * 3 + j) * 512 + kt * 64) * 1024 + nt * 64, 1024, WSP(bf16_t, WS_WBR) + ((size_t)j * 1024 + nt * 64) * 512 + kt * 64, 512, 64, nullptr); }
        else { const int q = t - 2424, nt = q >> 4, kt = q & 15;
            conv_tile(C, CIN(39) + ((size_t)l * 1024 + kt * 64) * 1024 + nt * 64, 1024, WSP(bf16_t, WS_WOUT) + (size_t)nt * 64 * 1024 + kt * 64, 1024, 64, nullptr); }
    }
}
__device__ __forceinline__ void phase_conv_moe(const Ctx& C, int l) {
    constexpr int TOTAL = 16 * 1152;
    LAS float* tile = (LAS float*)C.lds + C.wave * (64 * 65);
    const int r4 = C.lane >> 4, c4 = (C.lane & 15) * 4, nr = C.lane >> 3, ks = (C.lane & 7) * 8;
    const int t0 = C.bid * 8 + C.wave, S = C.G * 8;
    if (t0 >= TOTAL) return;
    const int n = (TOTAL - t0 + S - 1) / S;
#define CM_SRC(t_, src, sld) const float* src; int sld; { const int tq = (t_) < TOTAL ? (t_) : TOTAL - 1; const int e = tq / 1152, q = tq % 1152; \
        if (q < 768) { const int half = q / 384, r = q % 384, kt = r / 24, ct = r % 24; src = CIN(half ? 42 : 41) + ((size_t)(l * 16 + e) * 1024) * FF + (size_t)kt * 64 * FF + ct * 64; sld = FF; } \
        else { const int r = q - 768, kt = r >> 4, nt = r & 15; src = CIN(43) + ((size_t)(l * 16 + e) * FF) * 1024 + (size_t)kt * 64 * 1024 + nt * 64; sld = 1024; } }
#define CM_DST(t_, dst, dld) unsigned char* dst; int dld; { const int tq = (t_) < TOTAL ? (t_) : TOTAL - 1; const int e = tq / 1152, q = tq % 1152; \
        if (q < 768) { const int half = q / 384, r = q % 384, kt = r / 24, ct = r % 24; const int drow = (ct >> 1) * 256 + half * 128 + (ct & 1) * 64; dst = WSP(unsigned char, WS_W13) + ((size_t)e * 3072 + drow) * 1024 + kt * 64; dld = 1024; } \
        else { const int r = q - 768, kt = r >> 4, nt = r & 15; dst = WSP(unsigned char, WS_W2) + ((size_t)e * 1024 + nt * 64) * FF + kt * 64; dld = FF; } }
#define CM_LOAD(v, t_) do { CM_SRC(t_, src_, sld_); _Pragma("unroll") for (int i = 0; i < 16; ++i) v[i] = *(const f32x4*)(src_ + (size_t)(i * 4 + r4) * sld_ + c4); } while (0)
#define CM_PROC(v, t_) do { CM_DST(t_, dst_, dld_); \
        _Pragma("unroll") for (int i = 0; i < 16; ++i) { LAS float* tp = tile + (i * 4 + r4) * 65 + c4; tp[0] = v[i][0] * F8_SW; tp[1] = v[i][1] * F8_SW; tp[2] = v[i][2] * F8_SW; tp[3] = v[i][3] * F8_SW; } \
        asm volatile("s_waitcnt lgkmcnt(0)" ::: "memory"); \
        _Pragma("unroll") for (int i = 0; i < 8; ++i) { const int nn = i * 8 + nr; float o[8]; \
            _Pragma("unroll") for (int j = 0; j < 8; ++j) o[j] = tile[(ks + j) * 65 + nn]; \
            *(u32x2*)(dst_ + (size_t)nn * dld_ + ks) = (u32x2){pk4_fp8(o[0], o[1], o[2], o[3]), pk4_fp8(o[4], o[5], o[6], o[7])}; } \
        asm volatile("s_waitcnt lgkmcnt(0)" ::: "memory"); } while (0)
    f32x4 va[16], vb[16];
    CM_LOAD(va, t0);
    int k = 0;
    for (; k + 1 < n; k += 2) { const int t = t0 + k * S; CM_LOAD(vb, t + S); CM_PROC(va, t); CM_LOAD(va, t + 2 * S); CM_PROC(vb, t + S); }
    if (k < n) CM_PROC(va, t0 + k * S);
#undef CM_SRC
#undef CM_DST
#undef CM_LOAD
#undef CM_PROC
}

__device__ __forceinline__ void phase_ssm_prep(const Ctx& C) {
    LAS float* par = (LAS float*)C.lds;
    LAS float* Bb = par + 256;
    LAS float* Cc = Bb + 4096;
    LAS float* Ap = Cc + 4096;
    LAS float* Kt = Ap + 4352;
    const float* lam_re = CIN(9); const float* lam_im = CIN(10); const float* log_dt = CIN(11); const float* b_re = CIN(12); const float* b_im = CIN(13);
    const float* c_re = CIN(14); const float* c_im = CIN(15); const float* dsk = CIN(16);
    for (int un = C.G - 1 - C.bid; un < 128 && un >= 0; un += C.G) { const int l = un >> 5, g = un & 31;
        if (C.tid < 128) { const int j = C.tid >> 6, p = C.tid & 63; const float dt = __expf(log_dt[(l * 2 + j) * 32 + g]);
            const float lr = lam_re[((l * 2 + j) * 32 + g) * 64 + p], li = lam_im[((l * 2 + j) * 32 + g) * 64 + p];
            par[(j * 64 + p) * 2] = lr * dt; par[(j * 64 + p) * 2 + 1] = li * dt;
            const float mag = expf(lr * dt); float sn, cs; sincosf(li * dt, &sn, &cs); const float ar = mag * cs, ai = mag * sn, den = lr * lr + li * li, nr = ar - 1.0f, ni = ai;
            const float cr = (nr * lr + ni * li) / den, ci = (ni * lr - nr * li) / den;
            for (int ch = 0; ch < 16; ++ch) { const float br = b_re[((l * 32 + g) * 64 + p) * 16 + ch], bi = b_im[((l * 32 + g) * 64 + p) * 16 + ch];
                Bb[((j * 64 + p) * 16 + ch) * 2] = cr * br - ci * bi; Bb[((j * 64 + p) * 16 + ch) * 2 + 1] = cr * bi + ci * br; }
            if (true) { float* a16 = WSP(float, WS_A16) + (((l * 2 + j) * 32 + g) * 64 + p) * 2; const float m16 = expf(16.0f * lr * dt); float s16, c16; sincosf(16.0f * li * dt, &s16, &c16); a16[0] = m16 * c16; a16[1] = m16 * s16; }
        }
        for (int idx = C.tid; idx < 2048; idx += NTHREADS) { const int j = idx >> 10, ch = (idx >> 6) & 15, p = idx & 63;
            Cc[idx * 2] = c_re[(((l * 2 + j) * 32 + g) * 16 + ch) * 64 + p]; Cc[idx * 2 + 1] = c_im[(((l * 2 + j) * 32 + g) * 16 + ch) * 64 + p]; }
        __syncthreads();
        for (int idx = C.tid; idx < 2 * 17 * 64; idx += NTHREADS) { const int j = idx / 1088, r = idx % 1088, e = r >> 6, p = r & 63;
            const float m = expf((float)e * par[(j * 64 + p) * 2]); float sn, cs; sincosf((float)e * par[(j * 64 + p) * 2 + 1], &sn, &cs); Ap[idx * 2] = m * cs; Ap[idx * 2 + 1] = m * sn; }
        __syncthreads();
        for (int idx = C.tid; idx < 8192; idx += NTHREADS) { const int j = idx >> 12, tau = (idx >> 8) & 15, ch = (idx >> 4) & 15, cp = idx & 15; float s = 0.f;
            for (int p = 0; p < 64; ++p) { const float cr = Cc[((j * 16 + ch) * 64 + p) * 2], ci = Cc[((j * 16 + ch) * 64 + p) * 2 + 1], ar = Ap[((j * 17 + tau) * 64 + p) * 2], ai = Ap[((j * 17 + tau) * 64 + p) * 2 + 1];
                const float zr = cr * ar - ci * ai, zi = cr * ai + ci * ar; const float br = Bb[((j * 64 + p) * 16 + cp) * 2], bi = Bb[((j * 64 + p) * 16 + cp) * 2 + 1]; s += zr * br - zi * bi; }
            Kt[idx] = s; }
        __syncthreads();
        bf16_t* W1 = WSP(bf16_t, WS_W1S) + (size_t)(l * 32 + g) * 256 * 256; bf16_t* W3 = WSP(bf16_t, WS_W3S) + (size_t)(l * 32 + g) * 256 * 512;
        for (int pc = C.tid; pc < 8192; pc += NTHREADS) { const int n = pc >> 5, k0 = (pc & 31) * 8; const int j = n >> 7, p = (n >> 1) & 63, cim = n & 1, i = k0 >> 4, ch0 = k0 & 15; const int e = j == 0 ? 15 - i : i;
            const float ar = Ap[((j * 17 + e) * 64 + p) * 2], ai = Ap[((j * 17 + e) * 64 + p) * 2 + 1]; float o[8];
#pragma unroll
            for (int q = 0; q < 8; ++q) { const float br = Bb[((j * 64 + p) * 16 + ch0 + q) * 2], bi = Bb[((j * 64 + p) * 16 + ch0 + q) * 2 + 1]; o[q] = cim ? ar * bi + ai * br : ar * br - ai * bi; }
            *(u32x4*)(W1 + (size_t)n * 256 + k0) = pack8(o); }
        for (int pc = C.tid; pc < 16384; pc += NTHREADS) { const int n = pc >> 6, k0 = (pc & 63) * 8; const int i = n >> 4, ch = n & 15; float o[8];
            if (k0 < 256) { const int ip = k0 >> 4, cp0 = k0 & 15;
#pragma unroll
                for (int q = 0; q < 8; ++q) { float s = 0.f; if (ip <= i) s += Kt[((0 * 16 + (i - ip)) * 16 + ch) * 16 + cp0 + q]; if (ip >= i) s += Kt[((1 * 16 + (ip - i)) * 16 + ch) * 16 + cp0 + q];
                    if (ip == i && cp0 + q == ch) s += dsk[l * 512 + g * 16 + ch]; o[q] = s; } }
            else { const int kk = k0 - 256, j = kk >> 7, p0 = (kk & 127) >> 1; const int e = j == 0 ? i + 1 : 16 - i;
#pragma unroll
                for (int q = 0; q < 4; ++q) { const int p = p0 + q; const float cr = Cc[((j * 16 + ch) * 64 + p) * 2], ci = Cc[((j * 16 + ch) * 64 + p) * 2 + 1], ar = Ap[((j * 17 + e) * 64 + p) * 2], ai = Ap[((j * 17 + e) * 64 + p) * 2 + 1];
                    o[2 * q] = cr * ar - ci * ai; o[2 * q + 1] = -(cr * ai + ci * ar); } }
            *(u32x4*)(W3 + (size_t)n * 512 + k0) = pack8(o); }
        __syncthreads();
    }
}

__device__ __forceinline__ void phase_ssm_step2(const Ctx& C, int l) {
    const int gt = C.bid * NTHREADS + C.tid; if (gt >= 32 * 16 * 2 * 64) return;
    const int p = gt & 63, j = (gt >> 6) & 1, b = (gt >> 7) & 15, g = gt >> 11;
    const float* a16 = WSP(float, WS_A16) + (((l * 2 + j) * 32 + g) * 64 + p) * 2; const float ar = a16[0], ai = a16[1];
    const float* E = WSP(float, WS_E) + (size_t)g * NCHROW * 256 + j * 128 + p * 2; bf16_t* X = WSP(bf16_t, WS_UT) + (size_t)g * NCHROW * 512 + 256 + j * 128 + p * 2;
    float xr = 0.f, xi = 0.f;
#define S2_ROW(s_) ((s_) < 16 ? 2048 + b * 16 + (j == 0 ? (s_) : 15 - (s_)) : b * 128 + (j == 0 ? (s_) - 16 : 127 - ((s_) - 16)))
#define S2_LOAD(ev, s0_) do { _Pragma("unroll") for (int q = 0; q < 8; ++q) { const int s = (s0_) + q < 144 ? (s0_) + q : 143; ev[q] = *(const f32x2*)(E + (size_t)S2_ROW(s) * 256); } } while (0)
#define S2_FOLD(ev, s0_) do { _Pragma("unroll") for (int q = 0; q < 8; ++q) { const int s = (s0_) + q; *(unsigned*)(X + (size_t)S2_ROW(s) * 512) = pk2(xr, xi); const float nr = ar * xr - ai * xi + ev[q].x, ni = ar * xi + ai * xr + ev[q].y; xr = nr; xi = ni; } } while (0)
    f32x2 ea[8], eb[8];
    S2_LOAD(ea, 0);
    for (int s0 = 0; s0 < 144; s0 += 16) { S2_LOAD(eb, s0 + 8); S2_FOLD(ea, s0); S2_LOAD(ea, s0 + 16); S2_FOLD(eb, s0 + 8); }
#undef S2_ROW
#undef S2_LOAD
#undef S2_FOLD
}

__device__ __forceinline__ void moe_combine(const Ctx& C, int mys, f32x4 (&acc)[4]) {
    const bf16_t* Y = WSP(bf16_t, WS_YBUF);
#pragma unroll
    for (int i = 0; i < 4; ++i) acc[i] = (f32x4){0.f, 0.f, 0.f, 0.f};
    unsigned mask = (unsigned)__ballot(C.lane < 16 && mys >= 0);
    while (mask) {
        u32x2 w[4][4]; int cnt = 0;
#pragma unroll
        for (int q = 0; q < 4; ++q) if (mask) { const int e = __builtin_ctz(mask); mask &= mask - 1; const int s = __builtin_amdgcn_readlane(mys, e); ++cnt;
            const bf16_t* yr = Y + ((size_t)e * EROWS + s) * 1024 + 4 * C.lane;
#pragma unroll
            for (int i = 0; i < 4; ++i) w[q][i] = *(const u32x2*)(yr + 256 * i); }
#pragma unroll
        for (int q = 0; q < 4; ++q) if (q < cnt) {
#pragma unroll
            for (int i = 0; i < 4; ++i) { acc[i][0] += bflo(w[q][i].x); acc[i][1] += bfhi(w[q][i].x); acc[i][2] += bflo(w[q][i].y); acc[i][3] += bfhi(w[q][i].y); } }
    }
}
__device__ __forceinline__ void phase_norm1(const Ctx& C, int l) {
    const float* MODl = WSP(float, WS_MOD) + (size_t)l * 17 * 6144; const float* MODp = WSP(float, WS_MOD) + (size_t)(l - 1) * 17 * 6144;
    const float* g1 = CIN(6) + l * 1024; bf16_t* H = WSP(bf16_t, WS_H); unsigned char* H8 = WSP(unsigned char, WS_H8); bf16_t* XB = WSP(bf16_t, WS_XB);
    const int stride = C.G * 8; const bool first = (l == 0); const float* xl_src = CIN(0); const float* xc_src = CIN(2); const int* SL = WSP(int, WS_SLOT);
    f32x4 xnext[4]; u32x2 xnb[4]; int snext = -1;
#pragma unroll
    for (int i = 0; i < 4; ++i) { xnext[i] = (f32x4){0.f, 0.f, 0.f, 0.f}; xnb[i] = (u32x2){0u, 0u}; }
#define N1_LOAD(rw) do { if (first) { const float* p0 = (rw) < NL ? xl_src + (size_t)(rw) * 1024 : xc_src + (size_t)((rw) - NL) * 1024; \
            _Pragma("unroll") for (int i = 0; i < 4; ++i) xnext[i] = *(const f32x4*)(p0 + 4 * C.lane + 256 * i); } \
        else { _Pragma("unroll") for (int i = 0; i < 4; ++i) xnb[i] = *(const u32x2*)(XB + (size_t)(rw) * 1024 + 4 * C.lane + 256 * i); \
            if (C.lane < 16) snext = SL[(size_t)(rw) * 16 + C.lane]; } } while (0)
    { const int r0 = C.bid * 8 + C.wave; if (r0 < NT) N1_LOAD(r0); }
    for (int row = C.bid * 8 + C.wave; row < NT; row += stride) {
        const bool lat = row < NL; const int mrow = lat ? (row >> 11) : 16;
        bf16_t* xout = XB + (size_t)row * 1024;
        f32x4 x[4]; const int mys = snext;
#pragma unroll
        for (int i = 0; i < 4; ++i) x[i] = first ? xnext[i] : (f32x4){bflo(xnb[i].x), bfhi(xnb[i].x), bflo(xnb[i].y), bfhi(xnb[i].y)};
        { const int rn = row + stride; if (rn < NT) N1_LOAD(rn); }
        if (!first) { f32x4 a[4]; moe_combine(C, mys, a);
#pragma unroll
            for (int i = 0; i < 4; ++i) { const f32x4 g5 = *(const f32x4*)(MODp + (size_t)mrow * 6144 + 5 * 1024 + 4 * C.lane + 256 * i); x[i] += g5 * a[i]; } }
#pragma unroll
        for (int i = 0; i < 4; ++i) { u32x2 w; w.x = pk2(x[i][0], x[i][1]); w.y = pk2(x[i][2], x[i][3]); *(u32x2*)(xout + 4 * C.lane + 256 * i) = w; }
        float ss = 0.f;
#pragma unroll
        for (int i = 0; i < 4; ++i) ss += x[i][0] * x[i][0] + x[i][1] * x[i][1] + x[i][2] * x[i][2] + x[i][3] * x[i][3];
        ss = red64(ss); const float rstd = rsqrtf(ss * (1.0f / 1024.0f) + NORM_EPS);
#pragma unroll
        for (int i = 0; i < 4; ++i) { const int col = 4 * C.lane + 256 * i; const f32x4 gg = *(const f32x4*)(g1 + col), sh = *(const f32x4*)(MODl + (size_t)mrow * 6144 + col), sc = *(const f32x4*)(MODl + (size_t)mrow * 6144 + 1024 + col);
            const f32x4 h = (x[i] * rstd * gg) * (sc + 1.0f) + sh; u32x2 w; w.x = pk2(h[0], h[1]); w.y = pk2(h[2], h[3]); *(u32x2*)(H + (size_t)row * 1024 + col) = w;
            const f32x4 h8 = h * F8_SX; *(unsigned*)(H8 + (size_t)row * 1024 + col) = pk4_fp8(h8[0], h8[1], h8[2], h8[3]); }
    }
#undef N1_LOAD
}
__device__ __forceinline__ void phase_final(const Ctx& C) {
    const float* MODp = WSP(float, WS_MOD) + (size_t)(DEPTH - 1) * 17 * 6144; const bf16_t* XB = WSP(bf16_t, WS_XB); const int* SL = WSP(int, WS_SLOT);
    const int stride = C.G * 8; u32x2 xn[4]; int snext = -1;
#pragma unroll
    for (int i = 0; i < 4; ++i) xn[i] = (u32x2){0u, 0u};
    { const int r0 = C.bid * 8 + C.wave; if (r0 < NL) {
#pragma unroll
        for (int i = 0; i < 4; ++i) xn[i] = *(const u32x2*)(XB + (size_t)r0 * 1024 + 4 * C.lane + 256 * i);
        if (C.lane < 16) snext = SL[(size_t)r0 * 16 + C.lane]; } }
    for (int row = C.bid * 8 + C.wave; row < NL; row += stride) {
        u32x2 xb[4]; const int mys = snext;
#pragma unroll
        for (int i = 0; i < 4; ++i) xb[i] = xn[i];
        { const int rn = row + stride; if (rn < NL) {
#pragma unroll
            for (int i = 0; i < 4; ++i) xn[i] = *(const u32x2*)(XB + (size_t)rn * 1024 + 4 * C.lane + 256 * i);
            if (C.lane < 16) snext = SL[(size_t)rn * 16 + C.lane]; } }
        f32x4 a[4]; moe_combine(C, mys, a); float* xr = C.out + (size_t)row * 1024;
#pragma unroll
        for (int i = 0; i < 4; ++i) { const int col = 4 * C.lane + 256 * i; const f32x4 g5 = *(const f32x4*)(MODp + (size_t)(row >> 11) * 6144 + 5 * 1024 + col);
            *(f32x4*)(xr + col) = (f32x4){bflo(xb[i].x), bfhi(xb[i].x), bflo(xb[i].y), bfhi(xb[i].y)} + g5 * a[i]; }
    }
}
__device__ __forceinline__ void phase_router_prep(const Ctx& C, int l) {
    const float* MODl = WSP(float, WS_MOD) + (size_t)l * 17 * 6144; const float* g2 = CIN(7) + l * 1024; const float* rw = CIN(40) + (size_t)l * 1024 * 16;
    unsigned short* GRW = WSP(unsigned short, WS_GRW); float* GV = WSP(float, WS_GV); float* BIAS = WSP(float, WS_RBIAS);
    for (int idx = C.bid * NTHREADS + C.tid; idx < 17 * 16 * 1024; idx += C.G * NTHREADS) { const int k = idx & 1023, e = (idx >> 10) & 15, b = idx >> 14;
        const float gvv = g2[k] * (MODl[(size_t)b * 6144 + 4 * 1024 + k] + 1.0f); const float v = gvv * rw[k * 16 + e];
        const unsigned hi = pk2(v, 0.f) & 0xffffu; const float r1 = v - bflo(hi); const unsigned mid = pk2(r1, 0.f) & 0xffffu; const float r2 = r1 - bflo(mid); const unsigned lo = pk2(r2, 0.f) & 0xffffu;
        unsigned short* gp = GRW + ((size_t)(b * 3) * 16 + e) * 1024 + k; gp[0] = (unsigned short)hi; gp[16 * 1024] = (unsigned short)mid; gp[2 * 16 * 1024] = (unsigned short)lo;
        if (e == 0) GV[b * 1024 + k] = gvv; }
    if (C.bid < 17) { const int b = C.bid;
#pragma unroll
        for (int q = 0; q < 2; ++q) { const int e = C.wave * 2 + q; float s = 0.f;
            for (int i = 0; i < 16; ++i) { const int k = C.lane + 64 * i; s += MODl[(size_t)b * 6144 + 3 * 1024 + k] * rw[k * 16 + e]; }
            s = red64(s); if (C.lane == 0) BIAS[b * 16 + e] = s; } }
}
__device__ __forceinline__ void phase_norm2(const Ctx& C, int l, int nrows) {
    LAS float* part = (LAS float*)C.lds;
    LAS float* ssp = part + 2 * 8 * 64 * 4;
    const float* MODl = WSP(float, WS_MOD) + (size_t)l * 17 * 6144; bf16_t* H = WSP(bf16_t, WS_H); const bf16_t* XB = WSP(bf16_t, WS_XB); float* AFF = WSP(float, WS_AFF);
    const bf16_t* GRW = WSP(bf16_t, WS_GRW); const float* GV = WSP(float, WS_GV); const float* BIAS = WSP(float, WS_RBIAS);
    const int r = C.lane & 15, kq = C.lane >> 4, kw = C.wave * 128 + 8 * kq, nblk = nrows >> 4;
    u32x4 xa[4], xn[4];
#pragma unroll
    for (int c = 0; c < 4; ++c) xn[c] = (u32x4){0u, 0u, 0u, 0u};
    if (C.bid < nblk) {
#pragma unroll
        for (int c = 0; c < 4; ++c) xn[c] = *(const u32x4*)(XB + (size_t)(C.bid * 16 + r) * 1024 + kw + 32 * c); }
    int it = 0;
    for (int blk = C.bid; blk < nblk; blk += C.G, ++it) {
        const int row0 = blk * 16, b = row0 < NL ? (row0 >> 11) : 16, buf = it & 1;
#pragma unroll
        for (int c = 0; c < 4; ++c) xa[c] = xn[c];
        if (blk + C.G < nblk) {
#pragma unroll
            for (int c = 0; c < 4; ++c) xn[c] = *(const u32x4*)(XB + (size_t)((blk + C.G) * 16 + r) * 1024 + kw + 32 * c); }
        f32x4 acc = (f32x4){0.f, 0.f, 0.f, 0.f}; float ss = 0.f;
#pragma unroll
        for (int c = 0; c < 4; ++c) { const bf16x8 xo = __builtin_bit_cast(bf16x8, xa[c]);
#pragma unroll
            for (int s = 0; s < 3; ++s) { const bf16x8 go = *(const bf16x8*)(GRW + ((size_t)(b * 3 + s) * 16 + r) * 1024 + kw + 32 * c); acc = __builtin_amdgcn_mfma_f32_16x16x32_bf16(go, xo, acc, 0, 0, 0); }
            float f[8]; unpack8(xa[c], f);
#pragma unroll
            for (int j = 0; j < 8; ++j) ss += f[j] * f[j]; }
        ss += __shfl_xor(ss, 16); ss += __shfl_xor(ss, 32);
        *(LAS f32x4*)(part + ((buf * 8 + C.wave) * 64 + C.lane) * 4) = acc; if (C.lane < 16) ssp[(buf * 8 + C.wave) * 16 + C.lane] = ss;
        __syncthreads();
        float tot = 0.f;
#pragma unroll
        for (int w = 0; w < 8; ++w) tot += ssp[(buf * 8 + w) * 16 + r];
        const float rstd = rsqrtf(tot * (1.0f / 1024.0f) + NORM_EPS);
#pragma unroll
        for (int c = 0; c < 4; ++c) { const int k0 = kw + 32 * c; const f32x4 g0 = *(const f32x4*)(GV + b * 1024 + k0), g1 = *(const f32x4*)(GV + b * 1024 + k0 + 4);
            const f32x4 s0 = *(const f32x4*)(MODl + (size_t)b * 6144 + 3 * 1024 + k0), s1 = *(const f32x4*)(MODl + (size_t)b * 6144 + 3 * 1024 + k0 + 4);
            float f[8], h[8]; unpack8(xa[c], f);
#pragma unroll
            for (int j = 0; j < 4; ++j) { h[j] = (f[j] * rstd) * g0[j] + s0[j]; h[4 + j] = (f[4 + j] * rstd) * g1[j] + s1[j]; }
            *(u32x2*)((unsigned char*)H + (size_t)(row0 + r) * 1024 + k0) = (u32x2){pk4_fp8(h[0] * F8_SX, h[1] * F8_SX, h[2] * F8_SX, h[3] * F8_SX), pk4_fp8(h[4] * F8_SX, h[5] * F8_SX, h[6] * F8_SX, h[7] * F8_SX)}; }
        if (C.lane < 32) { const int rl = 2 * C.wave + (C.lane >> 4), e = C.lane & 15; float t2 = 0.f, lg = 0.f;
#pragma unroll
            for (int w = 0; w < 8; ++w) { t2 += ssp[(buf * 8 + w) * 16 + rl]; lg += part[((buf * 8 + w) * 64 + rl + 16 * (e >> 2)) * 4 + (e & 3)]; }
            lg = rsqrtf(t2 * (1.0f / 1024.0f) + NORM_EPS) * lg + BIAS[b * 16 + e];
            const float mx = max16(lg); const float ex = __expf(lg - mx); const float sum = red16(ex);
            AFF[(size_t)(row0 + rl) * 16 + e] = ex / sum; }
    }
    __syncthreads();
}

__device__ __forceinline__ void phase_topk(const Ctx& C, int nunits) {
    LAS unsigned* hist = (LAS unsigned*)C.lds;
    LAS unsigned* ctl = hist + 256;
    LAS unsigned* wsum = hist + 272;
    LAS int* lrow = (LAS int*)(hist + 288);
    const bf16_t* H = WSP(bf16_t, WS_H); unsigned char* XS = WSP(unsigned char, WS_XS);
    const float* AFF = WSP(float, WS_AFF); int* SLOT = WSP(int, WS_SLOT); int* IDX = WSP(int, WS_IDX); float* GATE = WSP(float, WS_GATE);
    for (int u = C.bid; u < nunits; u += C.G) {
        const bool lat = u < 256; const int b = (u & 255) >> 4, e = u & 15; const int n = lat ? 2048 : 256; const unsigned cap = lat ? 256u : 32u; const int row0 = lat ? b * 2048 : NL + b * 256; const int pos0 = lat ? b * 256 : 4096 + b * 32;
        unsigned key[4];
#pragma unroll
        for (int q = 0; q < 4; ++q) { const int idx = q * NTHREADS + C.tid; key[q] = idx < n ? __float_as_uint(AFF[(size_t)(row0 + idx) * 16 + e]) + 1u : 0u; }
        if (C.tid == 0) { ctl[0] = 0u; ctl[1] = cap; }
        unsigned prefix = 0u;
#pragma unroll 1
        for (int pass = 0; pass < 4; ++pass) {
            const int shift = 24 - 8 * pass; const unsigned himask = pass == 0 ? 0u : (0xffffffffu << (shift + 8));
            if (C.tid < 256) hist[C.tid] = 0u;
            __syncthreads();
#pragma unroll
            for (int q = 0; q < 4; ++q) if (key[q] != 0u && (key[q] & himask) == prefix) __hip_atomic_fetch_add(&hist[(key[q] >> shift) & 255u], 1u, __ATOMIC_RELAXED, __HIP_MEMORY_SCOPE_WORKGROUP);
            __syncthreads();
            if (C.wave == 0) {
                const unsigned remaining = ctl[1];
                const unsigned h0 = hist[4 * C.lane], h1 = hist[4 * C.lane + 1], h2 = hist[4 * C.lane + 2], h3 = hist[4 * C.lane + 3];
                unsigned s = h0 + h1 + h2 + h3;
#pragma unroll
                for (int d = 1; d < 64; d <<= 1) { const unsigned t = __shfl_down(s, d); if (C.lane + d < 64) s += t; }
                const unsigned above = s - (h0 + h1 + h2 + h3);
                const bool mine = s >= remaining && above < remaining;
                if (mine) { unsigned acc = above, bsel, cnt;
                    if (acc + h3 >= remaining) { bsel = 3u; cnt = h3; } else { acc += h3; if (acc + h2 >= remaining) { bsel = 2u; cnt = h2; } else { acc += h2; if (acc + h1 >= remaining) { bsel = 1u; cnt = h1; } else { acc += h1; bsel = 0u; cnt = h0; } } }
                    ctl[0] = prefix | ((4u * C.lane + bsel) << shift); ctl[1] = remaining - acc; ctl[2] = cnt; }
            }
            __syncthreads();
            prefix = ctl[0];
        }
        const unsigned thr = prefix, need_eq = ctl[1], cnt_eq = ctl[2];
        bool sel[4];
#pragma unroll
        for (int q = 0; q < 4; ++q) sel[q] = key[q] != 0u && key[q] >= thr;
        if (cnt_eq > need_eq) {
            unsigned base = 0u;
#pragma unroll 1
            for (int q = 0; q < 4; ++q) {
                const bool eq = key[q] == thr && thr != 0u; const unsigned long long bal = __ballot(eq); const unsigned lanepre = __builtin_popcountll(bal & ((1ull << C.lane) - 1ull));
                __syncthreads(); if (C.lane == 0) wsum[C.wave] = (unsigned)__builtin_popcountll(bal); __syncthreads();
                unsigned wpre = 0u, tot = 0u;
#pragma unroll
                for (int w = 0; w < 8; ++w) { const unsigned x = wsum[w]; if (w < C.wave) wpre += x; tot += x; }
                if (eq && base + wpre + lanepre >= need_eq) sel[q] = false;
                base += tot;
            }
        }
        const unsigned mycnt = (unsigned)sel[0] + (unsigned)sel[1] + (unsigned)sel[2] + (unsigned)sel[3];
        unsigned incl = mycnt;
#pragma unroll
        for (int d = 1; d < 64; d <<= 1) { const unsigned t = __shfl_up(incl, d); if (C.lane >= d) incl += t; }
        __syncthreads(); if (C.lane == 63) wsum[C.wave] = incl; __syncthreads();
        unsigned wpre = 0u;
#pragma unroll
        for (int w = 0; w < 8; ++w) if (w < C.wave) wpre += wsum[w];
        unsigned slot = wpre + incl - mycnt;
#pragma unroll
        for (int q = 0; q < 4; ++q) { const int idx = q * NTHREADS + C.tid; if (idx < n) { const int row = row0 + idx;
            if (sel[q]) { const int pos = pos0 + (int)slot; lrow[slot] = row; ++slot; SLOT[(size_t)row * 16 + e] = pos; IDX[e * EROWS + pos] = row; GATE[e * EROWS + pos] = __uint_as_float(key[q] - 1u); }
            else SLOT[(size_t)row * 16 + e] = -1; } }
        __syncthreads();
        for (int j0 = 0; j0 < (int)cap / 8; j0 += 8) { u32x4 v[8];
#pragma unroll
            for (int jj = 0; jj < 8; ++jj) { const int s = C.wave + 8 * (j0 + jj); const int srow = lrow[s < (int)cap ? s : 0]; v[jj] = *(const u32x4*)((const unsigned char*)H + (size_t)srow * 1024 + 16 * C.lane); }
#pragma unroll
            for (int jj = 0; jj < 8; ++jj) { const int s = C.wave + 8 * (j0 + jj); if (s < (int)cap) *(u32x4*)(XS + ((size_t)e * EROWS + pos0 + s) * 1024 + 16 * C.lane) = v[jj]; } }
        __syncthreads();
    }
}
__device__ __forceinline__ void phase_gather(const Ctx& C, int erows) {
    const int* IDX = WSP(int, WS_IDX); const bf16_t* H = WSP(bf16_t, WS_H); bf16_t* XS = WSP(bf16_t, WS_XS);
    for (int r = C.bid * 8 + C.wave; r < 16 * EROWS; r += C.G * 8) { if (r % EROWS >= erows) continue; const int src = __builtin_amdgcn_readfirstlane(IDX[r]);
        const u32x4* s = (const u32x4*)(H + (size_t)src * 1024); u32x4* d = (u32x4*)(XS + (size_t)r * 1024); d[C.lane] = s[C.lane]; d[C.lane + 64] = s[C.lane + 64]; }
}

__device__ __forceinline__ void phase_rwkv_pre(const Ctx& C, int l) {
    const bf16_t* P = WSP(bf16_t, WS_P); bf16_t* RK = WSP(bf16_t, WS_RKVK); bf16_t* LIN = WSP(bf16_t, WS_LIN);
    const float* mu = CIN(19) + l * 1920; const float* k_k = CIN(25) + l * 512;
    float muv[4][8], kkg[8];
#pragma unroll
    for (int r = 0; r < 4; ++r)
#pragma unroll
        for (int j = 0; j < 8; ++j) { const int col = (r * 64 + C.lane) * 8 + j; muv[r][j] = col < 1920 ? mu[col] : 0.f; }
#pragma unroll
    for (int j = 0; j < 8; ++j) kkg[j] = k_k[C.lane * 8 + j];
    const bool act3 = C.lane < 48;
    for (int run = C.bid * 8 + C.wave; run < NT / 16; run += C.G * 8) {
        const int row0 = run * 16; const bool lat = row0 < NL; const int tpos0 = lat ? (row0 & 2047) : ((row0 - NL) & 255); const int tlen = lat ? 2048 : 256;
        u32x4 pv[4], cu[4], nx[4];
        const u32x4 zero4 = (u32x4){0u, 0u, 0u, 0u};
#pragma unroll
        for (int r = 0; r < 4; ++r) { const bool ok = r < 3 || act3; const size_t off = (size_t)(r * 64 + C.lane) * 8;
            pv[r] = (ok && tpos0 > 0) ? *(const u32x4*)(P + (size_t)(row0 - 1) * LDP + off) : zero4;
            cu[r] = ok ? *(const u32x4*)(P + (size_t)row0 * LDP + off) : zero4; }
        for (int i = 0; i < 16; ++i) {
            const int row = row0 + i; const bool hasn = (tpos0 + i + 1) < tlen;
#pragma unroll
            for (int r = 0; r < 4; ++r) { const bool ok = r < 3 || act3; nx[r] = (ok && hasn) ? *(const u32x4*)(P + (size_t)(row + 1) * LDP + (size_t)(r * 64 + C.lane) * 8) : zero4; }
#pragma unroll
            for (int r = 0; r < 4; ++r) {
                float a[8], b[8], c[8], m[8]; unpack8(pv[r], a); unpack8(cu[r], c); unpack8(nx[r], b);
#pragma unroll
                for (int j = 0; j < 8; ++j) m[j] = c[j] + muv[r][j] * (0.5f * (a[j] + b[j]) - c[j]);
                if (r == 0) *(u32x4*)(RK + (size_t)row * 2048 + C.lane * 8) = pack8(m);
                if (r == 1) { *(u32x4*)(RK + (size_t)row * 2048 + 512 + C.lane * 8) = pack8(m); float ss = 0.f;
#pragma unroll
                    for (int j = 0; j < 8; ++j) { m[j] *= kkg[j]; ss += m[j] * m[j]; }
                    ss = red8(ss); const float rn = rsqrtf(ss + 1e-12f);
#pragma unroll
                    for (int j = 0; j < 8; ++j) m[j] *= rn;
                    *(u32x4*)(RK + (size_t)row * 2048 + 1536 + C.lane * 8) = pack8(m); }
                if (r == 2) *(u32x4*)(RK + (size_t)row * 2048 + 1024 + C.lane * 8) = pack8(m);
                if (r == 3 && act3) {
#pragma unroll
                    for (int j = 0; j < 8; ++j) { if (C.lane < 16) m[j] = 1.0f - 2.0f * __builtin_amdgcn_rcpf(__expf(2.0f * m[j]) + 1.0f); else if (C.lane >= 32) m[j] = sigmoidf_(m[j]); }
                    const int lc = C.lane < 8 ? C.lane * 8 : (C.lane < 16 ? 128 + (C.lane - 8) * 8 : (C.lane < 24 ? 64 + (C.lane - 16) * 8 : (C.lane < 32 ? 192 + (C.lane - 24) * 8 : C.lane * 8)));
                    *(u32x4*)(LIN + (size_t)row * 384 + lc) = pack8(m); }
            }
#pragma unroll
            for (int r = 0; r < 4; ++r) { pv[r] = cu[r]; cu[r] = nx[r]; }
        }
    }
}

typedef short s16x4 __attribute__((ext_vector_type(4)));
typedef __bf16 bf2_t __attribute__((ext_vector_type(2)));
__device__ __forceinline__ unsigned pkb(float lo, float hi) { const bf2_t v = __builtin_convertvector((f32x2){lo, hi}, bf2_t); return __builtin_bit_cast(unsigned, v); }
__device__ __forceinline__ s16x4 pack4(const f32x4& c) { return __builtin_bit_cast(s16x4, (u32x2){pkb(c[0], c[1]), pkb(c[2], c[3])}); }
#define MF32(a, b, c) __builtin_amdgcn_mfma_f32_16x16x32_bf16((a), (b), (c), 0, 0, 0)
#define MF16(a, b, c) __builtin_amdgcn_mfma_f32_16x16x16bf16_1k((a), (b), (c), 0, 0, 0)
#define RW_BAR() do { asm volatile("s_waitcnt lgkmcnt(0)" ::: "memory"); __builtin_amdgcn_s_barrier(); asm volatile("" ::: "memory"); } while (0)
constexpr int RW_RAW = 4 * 12288;
constexpr int RW_SLOT = 18432;
__device__ __forceinline__ int rw_token(int b, int dir, int pos) { return (pos < 256) ? (NL + b * 256 + (dir ? 255 - pos : pos)) : (b * 2048 + (dir ? 2047 - (pos - 256) : pos - 256)); }
__device__ __forceinline__ void phase_rwkv_scan(const Ctx& C, int l) {
    const bf16_t* RK = WSP(bf16_t, WS_RKVK); const bf16_t* LO = WSP(bf16_t, WS_LOUT); bf16_t* Y2 = WSP(bf16_t, WS_Y2);
    const int fr = C.lane & 15, g = C.lane >> 4;
    const f32x4 zero4 = (f32x4){0.f, 0.f, 0.f, 0.f};
    for (int item = C.bid; item < 256; item += C.G) {
        const int b = item >> 4, h = (item >> 1) & 7, dir = item & 1;
        if (C.wave < 4) {
            const int w = C.wave;
            f32x4 Hs[4] = {zero4, zero4, zero4, zero4};
            f32x4 Ic; bool mlt[4], mle[4], mgt[4];
#pragma unroll
            for (int j = 0; j < 4; ++j) { const int ri = 4 * g + j; Ic[j] = ri == fr ? 1.f : 0.f; mlt[j] = ri < fr; mle[j] = ri <= fr; mgt[j] = ri > fr; }
            RW_BAR();
#pragma unroll 1
            for (int i = -4; i < 144; ++i) {
                if (i >= 0) {
                    const LAS unsigned char* S = C.lds + RW_RAW + (i % 5) * RW_SLOT;
                    bf16x8 fKK[2], fR[2], fKD[2], fB[2];
#pragma unroll
                    for (int ks = 0; ks < 2; ++ks) { const int o = (fr * 68 + 32 * ks + 4 * g) * 2;
                        { const u32x2 lo = *(const LAS u32x2*)(S + o), hi = *(const LAS u32x2*)(S + o + 32); fKK[ks] = __builtin_bit_cast(bf16x8, (u32x4){lo.x, lo.y, hi.x, hi.y}); }
                        { const u32x2 lo = *(const LAS u32x2*)(S + 2176 + o), hi = *(const LAS u32x2*)(S + 2176 + o + 32); fR[ks] = __builtin_bit_cast(bf16x8, (u32x4){lo.x, lo.y, hi.x, hi.y}); }
                        { const u32x2 lo = *(const LAS u32x2*)(S + 4352 + o), hi = *(const LAS u32x2*)(S + 4352 + o + 32); fKD[ks] = __builtin_bit_cast(bf16x8, (u32x4){lo.x, lo.y, hi.x, hi.y}); }
                        { const u32x2 lo = *(const LAS u32x2*)(S + 6528 + o), hi = *(const LAS u32x2*)(S + 6528 + o + 32); fB[ks] = __builtin_bit_cast(bf16x8, (u32x4){lo.x, lo.y, hi.x, hi.y}); } }
                    const s16x4 fV = *(const LAS s16x4*)(S + 8704 + ((16 * w + fr) * 24 + 4 * g) * 2);
                    bf16x8 bH[2];
#pragma unroll
                    for (int ks = 0; ks < 2; ++ks) bH[ks] = __builtin_bit_cast(bf16x8, (u32x4){pkb(Hs[2 * ks][0], Hs[2 * ks][1]), pkb(Hs[2 * ks][2], Hs[2 * ks][3]), pkb(Hs[2 * ks + 1][0], Hs[2 * ks + 1][1]), pkb(Hs[2 * ks + 1][2], Hs[2 * ks + 1][3])});
                    f32x4 M1 = zero4, M2 = zero4, M2p = zero4, M3 = zero4, M4 = zero4, KH = zero4, RH = zero4;
#pragma unroll
                    for (int ks = 0; ks < 2; ++ks) { M2p = MF32(fKK[ks], fB[ks], M2p); M2 = MF32(fB[ks], fKK[ks], M2); M1 = MF32(fKD[ks], fKK[ks], M1); KH = MF32(fKK[ks], bH[ks], KH);
                        M3 = MF32(fKD[ks], fR[ks], M3); M4 = MF32(fB[ks], fR[ks], M4); RH = MF32(fR[ks], bH[ks], RH); }
                    f32x4 Nc, Ntc;
#pragma unroll
                    for (int j = 0; j < 4; ++j) { Nc[j] = mgt[j] ? M2p[j] : 0.f; Ntc[j] = mlt[j] ? M2[j] : 0.f; M1[j] = mlt[j] ? M1[j] : 0.f; M3[j] = mle[j] ? M3[j] : 0.f; M4[j] = mle[j] ? M4[j] : 0.f; }
                    const s16x4 pN = pack4(Nc), pNt = pack4(Ntc);
                    const f32x4 N2c = MF16(pNt, pN, zero4), N2tc = MF16(pN, pNt, zero4);
                    const f32x4 RHS = MF16(pack4(M1), fV, KH);
                    const s16x4 pN2 = pack4(N2c), pN2t = pack4(N2tc);
                    const f32x4 N4c = MF16(pN2t, pN2, zero4), N4tc = MF16(pN2, pN2t, zero4);
                    const f32x4 Z1c = MF16(pack4(Ic - Nc), pack4(Ic + N2tc), zero4);
                    const s16x4 pN4 = pack4(N4c), pN4t = pack4(N4tc);
                    const f32x4 N8tc = MF16(pN4, pN4t, zero4);
                    const f32x4 Z2tc = MF16(pack4(Z1c), pack4(Ic + N4c), zero4);
                    const f32x4 Z3c = MF16(pack4(Z2tc), pack4(Ic + N8tc), zero4);
                    const f32x4 Uc = MF16(pack4(Z3c), pack4(RHS), zero4);
                    const s16x4 nU = pack4(-Uc);
                    f32x4 Y = MF16(pack4(M3), fV, RH); Y = MF16(pack4(M4), nU, Y);
#pragma unroll
                    for (int mt = 0; mt < 4; ++mt) { const f32x4 p15 = *(const LAS f32x4*)(S + 17920 + (16 * mt + 4 * g) * 4);
                        const s16x4 aKD = *(const LAS s16x4*)(S + 11776 + ((16 * mt + fr) * 24 + 4 * g) * 2), aB = *(const LAS s16x4*)(S + 14848 + ((16 * mt + fr) * 24 + 4 * g) * 2);
                        f32x4 hh = Hs[mt] * p15; hh = MF16(aKD, fV, hh); Hs[mt] = MF16(aB, nU, hh); }
#pragma unroll
                    for (int j = 0; j < 4; ++j) { const int tok = rw_token(b, dir, 16 * i + 4 * g + j); Y2[((size_t)dir * NT + tok) * 512 + h * 64 + 16 * w + fr] = (bf16_t)(pkb(Y[j], 0.f) & 0xffffu); }
                }
                RW_BAR();
            }
        } else {
            const int pi = C.wave - 4; const float ka = CIN(26)[l * 512 + h * 64 + C.lane];
            LAS unsigned char* raw = C.lds + pi * 12288;
            const int rr = C.lane >> 3, seg = C.lane & 7;
            const int sgn = dir ? -1 : 1; int loff[3];
#pragma unroll
            for (int j3 = 0; j3 < 3; ++j3) { const int arr_ = 2 * j3 + (rr >> 2); loff[j3] = (arr_ < 4 ? sgn * (rr & 3) * 2048 + arr_ * 512 : sgn * (rr & 3) * 2560 + (arr_ - 4) * 1024 + dir * 512) + h * 64 + seg * 8; }
#define RW_ISSUE_Q(c, q) do { const int p0_ = 16 * (c); const int T0_ = (p0_ < 256 ? NL + b * 256 + (dir ? 255 - p0_ : p0_) : b * 2048 + (dir ? 2047 - (p0_ - 256) : p0_ - 256)) + sgn * 4 * (q); \
            _Pragma("unroll") for (int j3 = 0; j3 < 3; ++j3) { const bf16_t* sb_ = j3 < 2 ? RK + (size_t)T0_ * 2048 : LO + (size_t)T0_ * 2560;     \
                __builtin_amdgcn_global_load_lds((const unsigned*)(sb_ + loff[j3]), (LAS unsigned*)(raw + ((q) * 3 + j3) * 1024), 16, 0, 0); } } while (0)
            { const float kdum = ka; asm volatile("s_waitcnt vmcnt(0)" :: "v"(kdum) : "memory"); }
#pragma unroll
            for (int q = 0; q < 4; ++q) RW_ISSUE_Q(pi, q);
            asm volatile("s_waitcnt vmcnt(9)" ::: "memory"); RW_BAR();
            for (int z = 0; z < pi; ++z) { asm volatile("s_waitcnt vmcnt(9)" ::: "memory"); RW_BAR(); }
#pragma unroll 1
            for (int m = 0; m < 36; ++m) {
                const int c = pi + 4 * m;
                LAS unsigned char* S = C.lds + RW_RAW + (c % 5) * RW_SLOT;
                float cum = 0.f, emp = 1.0f, kdi_[16], bi_[16]; unsigned gv[16];
#pragma unroll
                for (int q = 0; q < 4; ++q) {
                    const LAS bf16_t* rw = (const LAS bf16_t*)raw + q * 3 * 512 + C.lane;
                    unsigned gr[4], gk[4], gkk[4], ge[4], gi[4];
#pragma unroll
                    for (int t = 0; t < 4; ++t) { gr[t] = rw[(0 * 8 + 0 + t) * 64]; gk[t] = rw[(0 * 8 + 4 + t) * 64]; gv[4 * q + t] = rw[(1 * 8 + 0 + t) * 64]; gkk[t] = rw[(1 * 8 + 4 + t) * 64]; ge[t] = rw[(2 * 8 + 0 + t) * 64]; gi[t] = rw[(2 * 8 + 4 + t) * 64]; }
                    __builtin_amdgcn_sched_barrier(0);
#pragma unroll
                    for (int t = 0; t < 4; ++t) { const int tt = 4 * q + t; const float r_ = bflo(gr[t]), k_ = bflo(gk[t]), kk_ = bflo(gkk[t]), e_ = bflo(ge[t]), a_ = bflo(gi[t]);
                        const float kd_ = k_ * (1.0f + (a_ - 1.0f) * ka), bb_ = kk_ * a_; cum += e_;
                        const float ep = __expf(cum), em = __expf(-cum); const float kkd = kk_ * emp, rd = r_ * em, kdi = kd_ * ep, bi = bb_ * ep; emp = em; kdi_[tt] = kdi; bi_[tt] = bi;
                        LAS bf16_t* rowp = (LAS bf16_t*)S + tt * 68 + C.lane;
                        const unsigned p0 = pkb(kkd, rd), p1 = pkb(kdi, bi);
                        rowp[0] = (bf16_t)(p0 & 0xffffu); rowp[1088] = (bf16_t)(p0 >> 16); rowp[2176] = (bf16_t)(p1 & 0xffffu); rowp[3264] = (bf16_t)(p1 >> 16); }
                    if (q == 3) { const float em15 = emp; unsigned wv[8], wk[8], wb[8];
#pragma unroll
                        for (int t2 = 0; t2 < 8; ++t2) {
                            wv[t2] = gv[2 * t2] | (gv[2 * t2 + 1] << 16); wk[t2] = pkb(kdi_[2 * t2] * em15, kdi_[2 * t2 + 1] * em15); wb[t2] = pkb(bi_[2 * t2] * em15, bi_[2 * t2 + 1] * em15); }
                        LAS u32x4* tv = (LAS u32x4*)(S + 8704 + C.lane * 48); tv[0] = (u32x4){wv[0], wv[1], wv[2], wv[3]}; tv[1] = (u32x4){wv[4], wv[5], wv[6], wv[7]};
                        LAS u32x4* tk = (LAS u32x4*)(S + 11776 + C.lane * 48); tk[0] = (u32x4){wk[0], wk[1], wk[2], wk[3]}; tk[1] = (u32x4){wk[4], wk[5], wk[6], wk[7]};
                        LAS u32x4* tb = (LAS u32x4*)(S + 14848 + C.lane * 48); tb[0] = (u32x4){wb[0], wb[1], wb[2], wb[3]}; tb[1] = (u32x4){wb[4], wb[5], wb[6], wb[7]};
                        *(LAS float*)(S + 17920 + C.lane * 4) = em15; }
                    asm volatile("s_waitcnt lgkmcnt(0)" ::: "memory");
                    if (c + 4 < 144) RW_ISSUE_Q(c + 4, q);
                    else { _Pragma("unroll") for (int j3 = 0; j3 < 3; ++j3) __builtin_amdgcn_global_load_lds((const unsigned*)RK, (LAS unsigned*)(raw + (q * 3 + j3) * 1024), 16, 0, 0); }
                    asm volatile("s_waitcnt vmcnt(9)" ::: "memory");
                    RW_BAR();
                }
            }
            for (int z = 0; z < 4 - pi; ++z) { asm volatile("s_waitcnt vmcnt(9)" ::: "memory"); RW_BAR(); }
            asm volatile("s_waitcnt vmcnt(0)" ::: "memory");
#undef RW_ISSUE_Q
        }
    }
}

__device__ __forceinline__ void phase_rwkv_out(const Ctx& C, int l, int nrows) {
    const bf16_t* RK = WSP(bf16_t, WS_RKVK); const bf16_t* LO = WSP(bf16_t, WS_LOUT); const bf16_t* Y2 = WSP(bf16_t, WS_Y2); bf16_t* O = WSP(bf16_t, WS_YBR1);
    float lw[8], lb[8], ka[8], rk[8];
#pragma unroll
    for (int j = 0; j < 8; ++j) { const int c = l * 512 + C.lane * 8 + j; lw[j] = CIN(28)[c]; lb[j] = CIN(29)[c]; ka[j] = CIN(26)[c]; rk[j] = CIN(27)[c]; }
    const int stride = C.G * 8, r0 = C.bid * 8 + C.wave;
    if (r0 >= nrows) return;
    const int T = (nrows - r0 + 2 * stride - 1) / (2 * stride);
#define RO_LOAD(ld, t_) do { _Pragma("unroll") for (int q = 0; q < 2; ++q) { const int rq_ = r0 + (2 * (t_) + q) * stride; const int row = rq_ < nrows ? rq_ : nrows - 1; \
            ld[q][0] = *(const u32x4*)(Y2 + (size_t)row * 512 + C.lane * 8); ld[q][1] = *(const u32x4*)(Y2 + ((size_t)NT + row) * 512 + C.lane * 8); \
            ld[q][2] = *(const u32x4*)(RK + (size_t)row * 2048 + C.lane * 8); ld[q][3] = *(const u32x4*)(RK + (size_t)row * 2048 + 512 + C.lane * 8); ld[q][4] = *(const u32x4*)(RK + (size_t)row * 2048 + 1024 + C.lane * 8); \
            ld[q][5] = *(const u32x4*)(LO + (size_t)row * 2560 + 1024 + C.lane * 8); ld[q][6] = *(const u32x4*)(LO + (size_t)row * 2560 + 1536 + C.lane * 8); ld[q][7] = *(const u32x4*)(LO + (size_t)row * 2560 + 2048 + C.lane * 8); } } while (0)
#define RO_PROC(ld, t_) do { _Pragma("unroll") for (int q = 0; q < 2; ++q) { const int rq_ = r0 + (2 * (t_) + q) * stride; const int row = rq_ < nrows ? rq_ : nrows - 1; \
            float y[8], t[8], r[8], k[8], v[8], i0[8], i1[8], g[8]; \
            unpack8(ld[q][0], y); unpack8(ld[q][1], t); unpack8(ld[q][2], r); unpack8(ld[q][3], k); unpack8(ld[q][4], v); unpack8(ld[q][5], i0); unpack8(ld[q][6], i1); unpack8(ld[q][7], g); \
            float s = 0.f, bs = 0.f; \
            _Pragma("unroll") for (int j = 0; j < 8; ++j) { y[j] += t[j]; s += y[j]; bs += r[j] * k[j] * (2.0f + (i0[j] + i1[j] - 2.0f) * ka[j]) * rk[j]; } \
            const float mean = red8(s) * (1.0f / 64.0f); bs = red8(bs); float qq = 0.f; \
            _Pragma("unroll") for (int j = 0; j < 8; ++j) { y[j] -= mean; qq += y[j] * y[j]; } \
            const float rstd = rsqrtf(red8(qq) * (1.0f / 64.0f) + GN_EPS); float o[8]; \
            _Pragma("unroll") for (int j = 0; j < 8; ++j) o[j] = (y[j] * rstd * lw[j] + lb[j] + bs * v[j]) * g[j]; \
            *(u32x4*)(O + (size_t)row * 512 + C.lane * 8) = pack8(o); } } while (0)
    u32x4 la[2][8], lb2[2][8];
    RO_LOAD(la, 0);
    int tt = 0;
    for (; tt + 1 < T; tt += 2) { RO_LOAD(lb2, tt + 1); RO_PROC(la, tt); RO_LOAD(la, tt + 2); RO_PROC(lb2, tt + 1); }
    if (tt < T) RO_PROC(la, tt);
#undef RO_LOAD
#undef RO_PROC
}

__device__ __forceinline__ void phase_mla_post(const Ctx& C, int l) {
    const bf16_t* P = WSP(bf16_t, WS_P); const bf16_t* QR = WSP(bf16_t, WS_QRAW); const bf16_t* KV = WSP(bf16_t, WS_KVRAW);
    bf16_t* Q = WSP(bf16_t, WS_Q); bf16_t* K = WSP(bf16_t, WS_K); bf16_t* V = WSP(bf16_t, WS_V);
    const int h = C.lane >> 3, sub = C.lane & 7;
    float gqn[8], gkn[8], gqr[4], gkr[4], frq[4];
#pragma unroll
    for (int j = 0; j < 8; ++j) { gqn[j] = CIN(34)[l * 64 + sub * 8 + j]; gkn[j] = CIN(35)[l * 64 + sub * 8 + j]; }
#pragma unroll
    for (int j = 0; j < 4; ++j) { gqr[j] = CIN(36)[l * 32 + sub * 4 + j]; gkr[j] = CIN(37)[l * 32 + sub * 4 + j]; const int i = (sub & 3) * 4 + j; frq[j] = exp2f(-(float)(i & 7) * (13.287712379549449f / 8.0f)); }
    const int stride = C.G * 8; const u32x4 z4 = (u32x4){0u, 0u, 0u, 0u};
    u32x4 n_pq = z4, n_pkv = z4, n_qn, n_kn, n_vv; u32x2 n_kr, n_qr;
#define MP_LOAD(rw_) do { const bf16_t* pr_ = P + (size_t)(rw_) * LDP; if (C.lane < 48) n_pq = *(const u32x4*)(pr_ + PC_MLA + C.lane * 8); if (C.lane < 32) n_pkv = *(const u32x4*)(pr_ + PC_CKV + C.lane * 8); \
        n_kr = *(const u32x2*)(pr_ + PC_KR + sub * 4); n_qn = *(const u32x4*)(QR + (size_t)(rw_) * 768 + h * 96 + sub * 8); n_qr = *(const u32x2*)(QR + (size_t)(rw_) * 768 + h * 96 + 64 + sub * 4); \
        n_kn = *(const u32x4*)(KV + (size_t)(rw_) * 1024 + h * 128 + sub * 8); n_vv = *(const u32x4*)(KV + (size_t)(rw_) * 1024 + h * 128 + 64 + sub * 8); } while (0)
    if (C.bid * 8 + C.wave < NT) MP_LOAD(C.bid * 8 + C.wave);
    for (int row = C.bid * 8 + C.wave; row < NT; row += stride) {
        const bool lat = row < NL; const int t = row & 2047;
        const u32x4 c_pq = n_pq, c_pkv = n_pkv, c_qn = n_qn, c_kn = n_kn, c_vv = n_vv; const u32x2 c_kr = n_kr, c_qr = n_qr;
        if (row + stride < NT) MP_LOAD(row + stride);
        float f[8]; float sq = 0.f, skv = 0.f;
        if (C.lane < 48) { unpack8(c_pq, f);
#pragma unroll
            for (int j = 0; j < 8; ++j) sq += f[j] * f[j]; }
        if (C.lane < 32) { unpack8(c_pkv, f);
#pragma unroll
            for (int j = 0; j < 8; ++j) skv += f[j] * f[j]; }
        const float rq = rsqrtf(red64(sq) * (1.0f / 384.0f) + NORM_EPS), rkv = rsqrtf(red64(skv) * (1.0f / 256.0f) + NORM_EPS);
        float cs[4], sn[4];
#pragma unroll
        for (int j = 0; j < 4; ++j) { if (lat) { const int i = (sub & 3) * 4 + j; const float pos = (float)(i < 8 ? (t >> 6) : (t & 63)); const float ang = pos * frq[j]; sn[j] = __sinf(ang); cs[j] = __cosf(ang); } else { cs[j] = 1.f; sn[j] = 0.f; } }
        float kr[4]; { const u32x2 w = c_kr; kr[0] = bflo(w.x); kr[1] = bfhi(w.x); kr[2] = bflo(w.y); kr[3] = bfhi(w.y); }
        { float s = kr[0] * kr[0] + kr[1] * kr[1] + kr[2] * kr[2] + kr[3] * kr[3]; const float rn = rsqrtf(red8(s) * (1.0f / 32.0f) + NORM_EPS);
#pragma unroll
          for (int j = 0; j < 4; ++j) kr[j] *= rn * gkr[j];
#pragma unroll
          for (int j = 0; j < 4; ++j) { const float pt = __shfl_xor(kr[j], 4); const float own = kr[j]; kr[j] = sub < 4 ? own * cs[j] - pt * sn[j] : pt * sn[j] + own * cs[j]; } }
        { float qn[8]; unpack8(c_qn, qn); float s = 0.f;
#pragma unroll
          for (int j = 0; j < 8; ++j) { qn[j] *= rq; s += qn[j] * qn[j]; }
          const float rn = rsqrtf(red8(s) * (1.0f / 64.0f) + NORM_EPS) * QSCALE;
#pragma unroll
          for (int j = 0; j < 8; ++j) qn[j] *= rn * gqn[j];
          *(u32x4*)(Q + ((size_t)row * 8 + h) * 96 + sub * 8) = pack8(qn);
          float qr[4]; { const u32x2 w = c_qr; qr[0] = bflo(w.x) * rq; qr[1] = bfhi(w.x) * rq; qr[2] = bflo(w.y) * rq; qr[3] = bfhi(w.y) * rq; }
          float s2 = qr[0] * qr[0] + qr[1] * qr[1] + qr[2] * qr[2] + qr[3] * qr[3]; const float rn2 = rsqrtf(red8(s2) * (1.0f / 32.0f) + NORM_EPS);
#pragma unroll
          for (int j = 0; j < 4; ++j) qr[j] *= rn2 * gqr[j];
#pragma unroll
          for (int j = 0; j < 4; ++j) { const float pt = __shfl_xor(qr[j], 4); const float own = qr[j]; qr[j] = (sub < 4 ? own * cs[j] - pt * sn[j] : pt * sn[j] + own * cs[j]) * QSCALE; }
          u32x2 w; w.x = pk2(qr[0], qr[1]); w.y = pk2(qr[2], qr[3]); *(u32x2*)(Q + ((size_t)row * 8 + h) * 96 + 64 + sub * 4) = w; }
        { float kn[8]; unpack8(c_kn, kn); float s = 0.f;
#pragma unroll
          for (int j = 0; j < 8; ++j) { kn[j] *= rkv; s += kn[j] * kn[j]; }
          const float rn = rsqrtf(red8(s) * (1.0f / 64.0f) + NORM_EPS);
#pragma unroll
          for (int j = 0; j < 8; ++j) kn[j] *= rn * gkn[j];
          *(u32x4*)(K + ((size_t)row * 8 + h) * 96 + sub * 8) = pack8(kn);
          u32x2 w; w.x = pk2(kr[0], kr[1]); w.y = pk2(kr[2], kr[3]); *(u32x2*)(K + ((size_t)row * 8 + h) * 96 + 64 + sub * 4) = w;
          float vv[8]; unpack8(c_vv, vv);
#pragma unroll
          for (int j = 0; j < 8; ++j) vv[j] *= rkv;
          *(u32x4*)(V + ((size_t)row * 8 + h) * 64 + sub * 8) = pack8(vv); }
    }
#undef MP_LOAD
}

__device__ __forceinline__ void phase_merge_sum(const Ctx& C, int nrows) {
    const bf16_t* P = WSP(bf16_t, WS_P); const bf16_t* BR = WSP(bf16_t, WS_BR); bf16_t* O = WSP(bf16_t, WS_MERGED);
    const int stride = C.G * 8, r0 = C.bid * 8 + C.wave;
    if (r0 < nrows) {
#define MS_LOAD(b, g, rw_) do { const int rq_ = (rw_); const int rw = rq_ < nrows ? rq_ : nrows - 1; const unsigned char* gp = (const unsigned char*)(P + (size_t)rw * LDP + PC_GATE);     \
        _Pragma("unroll") for (int j = 0; j < 3; ++j) _Pragma("unroll") for (int i = 0; i < 2; ++i) { const int col = 8 * C.lane + 512 * i; b[j][i] = *(const u32x4*)(BR + ((size_t)j * NT + rw) * 1024 + col); g[j][i] = *(const u32x2*)(gp + j * 1024 + col); } } while (0)
#define MS_PROC(b, g, rw_) do { const int rq_ = (rw_); const int row = rq_ < nrows ? rq_ : nrows - 1;     \
        _Pragma("unroll") for (int i = 0; i < 2; ++i) { float o[8]; \
            _Pragma("unroll") for (int q = 0; q < 8; ++q) o[q] = 0.f; \
            _Pragma("unroll") for (int j = 0; j < 3; ++j) { float bv[8], gv[8]; unpack8(b[j][i], bv); \
                { typedef float f32x2_ __attribute__((ext_vector_type(2))); const f32x2_ p0 = __builtin_amdgcn_cvt_pk_f32_fp8((int)g[j][i].x, false), p1 = __builtin_amdgcn_cvt_pk_f32_fp8((int)g[j][i].x, true), \
                    p2 = __builtin_amdgcn_cvt_pk_f32_fp8((int)g[j][i].y, false), p3 = __builtin_amdgcn_cvt_pk_f32_fp8((int)g[j][i].y, true); \
                  gv[0] = p0[0]; gv[1] = p0[1]; gv[2] = p1[0]; gv[3] = p1[1]; gv[4] = p2[0]; gv[5] = p2[1]; gv[6] = p3[0]; gv[7] = p3[1]; } \
                _Pragma("unroll") for (int q = 0; q < 8; ++q) o[q] += sigmoidf_(gv[q] * (1.0f / F8_SG)) * bv[q]; } \
            *(u32x4*)(O + (size_t)row * 1024 + 8 * C.lane + 512 * i) = pack8(o); } } while (0)
        u32x4 ba[3][2], bb[3][2]; u32x2 ga[3][2], gb[3][2];
        MS_LOAD(ba, ga, r0);
        for (int rr = r0; rr < nrows; rr += 2 * stride) { MS_LOAD(bb, gb, rr + stride); MS_PROC(ba, ga, rr); MS_LOAD(ba, ga, rr + 2 * stride); MS_PROC(bb, gb, rr + stride); }
#undef MS_LOAD
#undef MS_PROC
    }
}

__device__ __forceinline__ void phase_attn(const Ctx& C, int nunits) {
    const bf16_t* Q = WSP(bf16_t, WS_Q); const bf16_t* K = WSP(bf16_t, WS_K); const bf16_t* V = WSP(bf16_t, WS_V); bf16_t* O = WSP(bf16_t, WS_YBR2);
    LAS bf16_t* Kb = (LAS bf16_t*)C.lds;
    LAS bf16_t* Vb = Kb + 2 * 64 * 104;
    const int fr = C.lane & 15, g = C.lane >> 4, skey = C.tid >> 3, spc = C.tid & 7;
    for (int u = C.bid; u < nunits; u += C.G) {
        const bool lat = u < 1024; const int b = lat ? (u >> 6) : ((u - 1024) >> 3), h = lat ? ((u >> 3) & 7) : ((u - 1024) & 7), qt = lat ? (u & 7) : 0;
        const int qbase = (lat ? b * 2048 + qt * 256 : NL + b * 256) + C.wave * 32; const int nkt = lat ? 36 : 4;
        bf16x8 bq[2][3];
#pragma unroll
        for (int qi = 0; qi < 2; ++qi)
#pragma unroll
            for (int ks = 0; ks < 3; ++ks) bq[qi][ks] = *(const bf16x8*)(Q + ((size_t)(qbase + qi * 16 + fr) * 8 + h) * 96 + ks * 32 + g * 8);
        float mrun[2] = {0.f, 0.f};
        f32x4 ot[5][2];
#pragma unroll
        for (int dt = 0; dt < 5; ++dt) { ot[dt][0] = (f32x4){0.f, 0.f, 0.f, 0.f}; ot[dt][1] = ot[dt][0]; }
        const bf16x8 ones8 = __builtin_bit_cast(bf16x8, (u32x4){0x3f803f80u, 0x3f803f80u, 0x3f803f80u, 0x3f803f80u});
        u32x4 k0, k1, v0;
#define AT_LOAD(kt) do { const int tok_ = (((kt) < 4) ? NL + b * 256 + (kt) * 64 : b * 2048 + ((kt) - 4) * 64) + skey; const bf16_t* kp_ = K + ((size_t)tok_ * 8 + h) * 96; \
        k0 = *(const u32x4*)(kp_ + spc * 8); k1 = spc < 4 ? *(const u32x4*)(kp_ + 64 + spc * 8) : (u32x4){0u, 0u, 0u, 0u}; v0 = *(const u32x4*)(V + ((size_t)tok_ * 8 + h) * 64 + spc * 8); } while (0)
#define AT_WRITE(bufi) do { LAS bf16_t* kd_ = Kb + (bufi) * 6656 + skey * 104; *(LAS u32x4*)(kd_ + spc * 8) = k0; if (spc < 4) *(LAS u32x4*)(kd_ + 64 + spc * 8) = k1; \
        *(LAS u32x4*)(Vb + (bufi) * 4608 + skey * 72 + spc * 8) = v0; } while (0)
        AT_LOAD(0); AT_WRITE(0);
        __syncthreads();
        for (int kt = 0; kt < nkt; ++kt) {
            const int bi = kt & 1;
            if (kt + 1 < nkt) AT_LOAD(kt + 1);
            const LAS bf16_t* Kc = Kb + bi * 6656; const LAS bf16_t* Vc = Vb + bi * 4608;
            f32x4 st[2][4];
#pragma unroll
            for (int k4 = 0; k4 < 4; ++k4) { st[0][k4] = (f32x4){-mrun[0], -mrun[0], -mrun[0], -mrun[0]}; st[1][k4] = (f32x4){-mrun[1], -mrun[1], -mrun[1], -mrun[1]}; }
#pragma unroll
            for (int k4 = 0; k4 < 4; ++k4)
#pragma unroll
                for (int ks = 0; ks < 3; ++ks) { const bf16x8 a = *(const LAS bf16x8*)(Kc + (k4 * 16 + fr) * 104 + ks * 32 + g * 8);
                    st[0][k4] = __builtin_amdgcn_mfma_f32_16x16x32_bf16(a, bq[0][ks], st[0][k4], 0, 0, 0); st[1][k4] = __builtin_amdgcn_mfma_f32_16x16x32_bf16(a, bq[1][ks], st[1][k4], 0, 0, 0);
                    if (ks == 2 && (k4 & 1)) __builtin_amdgcn_sched_barrier(0); }
            bf16x8 bp[2][2];
#pragma unroll
            for (int qi = 0; qi < 2; ++qi) {
                float mx = st[qi][0][0];
#pragma unroll
                for (int k4 = 0; k4 < 4; ++k4)
#pragma unroll
                    for (int r = 0; r < 4; ++r) mx = fmaxf(mx, st[qi][k4][r]);
                if (!__all(mx <= 8.0f)) { mx = fmaxf(mx, __shfl_xor(mx, 16)); mx = fmaxf(mx, __shfl_xor(mx, 32)); const float dlt = mx; const float alpha = __builtin_amdgcn_exp2f(-dlt); mrun[qi] += dlt;
#pragma unroll
                    for (int dt = 0; dt < 5; ++dt) ot[dt][qi] *= alpha;
#pragma unroll
                    for (int k4 = 0; k4 < 4; ++k4) st[qi][k4] -= dlt; }
#pragma unroll
                for (int k4 = 0; k4 < 4; ++k4)
#pragma unroll
                    for (int r = 0; r < 4; ++r) st[qi][k4][r] = __builtin_amdgcn_exp2f(st[qi][k4][r]);
#pragma unroll
                for (int kb = 0; kb < 2; ++kb) { u32x4 w; w.x = pk2(st[qi][2 * kb][0], st[qi][2 * kb][1]); w.y = pk2(st[qi][2 * kb][2], st[qi][2 * kb][3]); w.z = pk2(st[qi][2 * kb + 1][0], st[qi][2 * kb + 1][1]); w.w = pk2(st[qi][2 * kb + 1][2], st[qi][2 * kb + 1][3]);
                    bp[qi][kb] = __builtin_bit_cast(bf16x8, w); }
                __builtin_amdgcn_sched_barrier(0);
            }
            {
                const unsigned vaddr = (unsigned)(size_t)(Vc + (4 * g + (fr >> 2)) * 72 + 4 * (fr & 3));
                u32x2 vt[4][2][2];
#define AT_TR(dt, kb, hh) "ds_read_b64_tr_b16 %" #dt #kb #hh ", %[a] offset:"
                asm volatile(
                    "ds_read_b64_tr_b16 %0, %16 offset:0\n\tds_read_b64_tr_b16 %1, %16 offset:2304\n\tds_read_b64_tr_b16 %2, %16 offset:4608\n\tds_read_b64_tr_b16 %3, %16 offset:6912\n\t"
                    "ds_read_b64_tr_b16 %4, %16 offset:32\n\tds_read_b64_tr_b16 %5, %16 offset:2336\n\tds_read_b64_tr_b16 %6, %16 offset:4640\n\tds_read_b64_tr_b16 %7, %16 offset:6944\n\t"
                    "ds_read_b64_tr_b16 %8, %16 offset:64\n\tds_read_b64_tr_b16 %9, %16 offset:2368\n\tds_read_b64_tr_b16 %10, %16 offset:4672\n\tds_read_b64_tr_b16 %11, %16 offset:6976\n\t"
                    "ds_read_b64_tr_b16 %12, %16 offset:96\n\tds_read_b64_tr_b16 %13, %16 offset:2400\n\tds_read_b64_tr_b16 %14, %16 offset:4704\n\tds_read_b64_tr_b16 %15, %16 offset:7008\n\t"
                    "s_waitcnt lgkmcnt(0)"
                    : "=&v"(vt[0][0][0]), "=&v"(vt[0][0][1]), "=&v"(vt[0][1][0]), "=&v"(vt[0][1][1]), "=&v"(vt[1][0][0]), "=&v"(vt[1][0][1]), "=&v"(vt[1][1][0]), "=&v"(vt[1][1][1]),
                      "=&v"(vt[2][0][0]), "=&v"(vt[2][0][1]), "=&v"(vt[2][1][0]), "=&v"(vt[2][1][1]), "=&v"(vt[3][0][0]), "=&v"(vt[3][0][1]), "=&v"(vt[3][1][0]), "=&v"(vt[3][1][1])
                    : "v"(vaddr) : "memory");
#undef AT_TR
#pragma unroll
                for (int dt = 0; dt < 4; ++dt)
#pragma unroll
                    for (int kb = 0; kb < 2; ++kb) { const bf16x8 a = __builtin_bit_cast(bf16x8, (u32x4){vt[dt][kb][0].x, vt[dt][kb][0].y, vt[dt][kb][1].x, vt[dt][kb][1].y});
                        ot[dt][0] = __builtin_amdgcn_mfma_f32_16x16x32_bf16(a, bp[0][kb], ot[dt][0], 0, 0, 0); ot[dt][1] = __builtin_amdgcn_mfma_f32_16x16x32_bf16(a, bp[1][kb], ot[dt][1], 0, 0, 0); }
#pragma unroll
                for (int kb = 0; kb < 2; ++kb) { ot[4][0] = __builtin_amdgcn_mfma_f32_16x16x32_bf16(ones8, bp[0][kb], ot[4][0], 0, 0, 0); ot[4][1] = __builtin_amdgcn_mfma_f32_16x16x32_bf16(ones8, bp[1][kb], ot[4][1], 0, 0, 0); }
            }
            if (kt + 1 < nkt) AT_WRITE(bi ^ 1);
            __syncthreads();
        }
#pragma unroll
        for (int qi = 0; qi < 2; ++qi) { const float inv = __builtin_amdgcn_rcpf(ot[4][qi][0]);
            bf16_t* op = O + (size_t)(qbase + qi * 16 + fr) * 512 + h * 64 + 4 * g;
#pragma unroll
            for (int dt = 0; dt < 4; ++dt) { const f32x4 o = ot[dt][qi] * inv; u32x2 w; w.x = pk2(o[0], o[1]); w.y = pk2(o[2], o[3]); *(u32x2*)(op + dt * 16) = w; } }
#undef AT_LOAD
#undef AT_WRITE
    }
}

#ifndef PROBE_BODIES
#define PROBE_BODIES 0u
#endif
#ifndef MK_PER_PHASE
#define MK_PER_PHASE 0
#endif
constexpr int NPH_LAYER = 13, PH_FINAL = 1 + NPH_LAYER * DEPTH, NPHASES = PH_FINAL + 1;

__global__ void __launch_bounds__(NTHREADS, 2) trunk_fwd(Args args) {
    extern __shared__ __attribute__((aligned(16))) unsigned char lds_raw[];
    Ctx C;
    C.A = (const __attribute__((address_space(4))) Args*)__builtin_amdgcn_kernarg_segment_ptr();
    C.out = args.out; C.ws = args.ws; C.lds = (LAS unsigned char*)lds_raw;
    C.tid = threadIdx.x; C.lane = C.tid & 63; C.wave = __builtin_amdgcn_readfirstlane(C.tid >> 6); C.G = gridDim.x; C.bid = blockIdx.x;
    LAS unsigned char* lds = C.lds;
    volatile LAS unsigned* misc = (volatile LAS unsigned*)(lds + LDS_BYTES - 64);
    if (C.tid < 4) misc[C.tid] = 0u;
    __syncthreads();
    XcdBarrier bar = xcd_barrier_post((unsigned*)(C.ws + WS_CTL) + 4096, misc);
#define SEAM() xcd_barrier(bar)
    const int lo = args.ph_lo, hi = args.ph_hi; const unsigned bmask = args.bmask;
#define BODY(k) if (bmask & (1u << (k)))
#define FRESH() do { const __attribute__((address_space(4))) Args* a_ = (const __attribute__((address_space(4))) Args*)__builtin_amdgcn_kernarg_segment_ptr(); \
        GAS unsigned char* w_ = (GAS unsigned char*)args.ws; GAS float* o_ = (GAS float*)args.out; int t_ = threadIdx.x; asm volatile("" : "+s"(a_), "+s"(w_), "+s"(o_), "+v"(t_)); \
        C.A = a_; C.ws = (unsigned char*)w_; C.out = (float*)o_; C.tid = t_; C.lane = t_ & 63; C.wave = __builtin_amdgcn_readfirstlane(t_ >> 6); } while (0)
#ifndef PHDIS
#define PHDIS 0
#endif
#define PHEN(k) (!((PHDIS >> (k)) & 1))
#define IN(k) (lo <= (k) && (k) < hi)
#define ENDPH(k) do { if (IN((k) + 1)) SEAM(); } while (0)

    if (IN(0)) { FRESH(); phase_ada(C); phase_ssm_prep(C); ENDPH(0); }

    for (int l = 0; l < DEPTH; ++l) {
        const int base = 1 + NPH_LAYER * l;
        if (base + NPH_LAYER <= lo || base >= hi) continue;
        const bool lastl = (l == DEPTH - 1);
        const int nMt = lastl ? NL / 256 : NT / 256, nrt = lastl ? NL : NT;
        const bool elem_first = (C.bid >> 3) & 1;
        if (PHEN(0) && IN(base + 0)) { FRESH(); BODY(0) { phase_conv_small(C, l); phase_router_prep(C, l); } BODY(1) phase_norm1(C, l); ENDPH(base + 0); }
        if (PHEN(1) && IN(base + 1)) { FRESH();
            BODY(2) { { pg8::Gemm g{WSP(bf16_t, WS_H), WSP(bf16_t, WS_WIN), 1024, 1024, 1024, 0, 0}; pg8::GroupOrder S; S.init(NT / 256, WIN_NB16, 1, C.G, C.bid);
              EpiWin E{WSP(bf16_t, WS_P), WSP(bf16_t, WS_UT), 0, 1.0f}; pg8::gemm_phase(lds, C.tid, g, S, E); }
              __syncthreads();
              { pg8::Gemm g{WSP(bf16_t, WS_H8), WSP(bf16_t, WS_WIN8) + (size_t)WIN_NB16 * 256 * 512, 1024, 1024, 1024, 0, 0};   pg8::GroupOrder S; S.init(NT / 256, 24 - WIN_NB16, 1, C.G, C.bid, (NT / 256 * WIN_NB16) % 256);
              EpiWin E{WSP(bf16_t, WS_P), WSP(bf16_t, WS_UT), WIN_NB16, 1.0f / (F8_SX * F8_SW)}; pg8::gemm_phase<EpiWin, pg8::GroupOrder, true>(lds, C.tid, g, S, E); } } ENDPH(base + 1); }
        if (PHEN(2) && IN(base + 2)) { FRESH();
            if (elem_first) { BODY(6) phase_rwkv_pre(C, l); __syncthreads(); }
            BODY(2) { pg8::Gemm g{WSP(bf16_t, WS_H8), WSP(bf16_t, WS_WIN8) + (size_t)6144 * 512, 1024, 1024, 1024, 0, 0};   pg8::GroupOrder S; S.init(NT / 256, 1, 1, C.G, C.bid);
              EpiWin E{WSP(bf16_t, WS_P), WSP(bf16_t, WS_UT), 24, 1.0f / (F8_SX * F8_SW)}; pg8::gemm_phase<EpiWin, pg8::GroupOrder, true>(lds, C.tid, g, S, E); }
            __syncthreads();
            BODY(3) { pg8::Gemm g{WSP(bf16_t, WS_UT), WSP(bf16_t, WS_W1S) + (size_t)l * 32 * 256 * 256, 512, 256, 256, (size_t)NCHROW * 512 * 2, (size_t)256 * 256 * 2}; pg8::GroupOrder S; S.init(NCHROW / 256, 1, 32, C.G, C.bid, 144);
              EpiSsmE E{WSP(float, WS_E)}; pg8::gemm_phase(lds, C.tid, g, S, E); }
            __syncthreads();
            BODY(4) { pg8::Gemm g{WSP(bf16_t, WS_P) + PC_MLA, WSP(bf16_t, WS_WUQ), LDP, 384, 384, 0, 0}; pg8::GroupOrder S; S.init(nMt, 3, 1, C.G, C.bid, 176);
              EpiBf16 E{WSP(bf16_t, WS_QRAW), 768, 0}; pg8::gemm_phase(lds, C.tid, g, S, E); }
            __syncthreads();
            BODY(5) { pg8::Gemm g{WSP(bf16_t, WS_P) + PC_CKV, WSP(bf16_t, WS_WUKV), LDP, 256, 256, 0, 0}; pg8::GroupOrder S; S.init(NT / 256, 4, 1, C.G, C.bid, 96);
              EpiBf16 E{WSP(bf16_t, WS_KVRAW), 1024, 0}; pg8::gemm_phase(lds, C.tid, g, S, E); }
            __syncthreads();
            if (!elem_first) { BODY(6) phase_rwkv_pre(C, l); }
            ENDPH(base + 2); }
        if (PHEN(3) && IN(base + 3)) { FRESH();
            if (elem_first) { BODY(9) phase_mla_post(C, l); __syncthreads(); }
            BODY(7) phase_ssm_step2(C, l);
            BODY(8) { int k128 = 128; asm volatile("" : "+s"(k128));
              { pg8::Gemm g{WSP(bf16_t, WS_LIN), WSP(bf16_t, WS_WLORA), 384, 128, k128, (size_t)128 * 2, (size_t)1024 * 128 * 2}; pg8::GroupOrder S; S.init(NT / 256, 4, 2, C.G, C.bid, 128);
                EpiLora E{WSP(bf16_t, WS_LOUT), CIN(20) + l * 1024, CIN(22) + l * 1024}; pg8::gemm_phase(lds, C.tid, g, S, E); }
              __syncthreads();
              { pg8::Gemm g{WSP(bf16_t, WS_LIN) + 256, WSP(bf16_t, WS_WLORA) + (size_t)2 * 1024 * 128, 384, 128, k128, 0, 0}; pg8::GroupOrder S; S.init(NT / 256, 2, 1, C.G, C.bid, 160);
                EpiBf16 E{WSP(bf16_t, WS_LOUT) + 2048, 2560, 0}; pg8::gemm_phase(lds, C.tid, g, S, E); } }
            __syncthreads();
            if (!elem_first) { BODY(9) phase_mla_post(C, l); }
            ENDPH(base + 3); }
        if (PHEN(4) && IN(base + 4)) { FRESH();
            BODY(10) phase_rwkv_scan(C, l);
            __syncthreads();
            BODY(11) phase_attn(C, lastl ? 1024 : 1152);
            __syncthreads();
            BODY(12) { pg8::Gemm g{WSP(bf16_t, WS_UT), WSP(bf16_t, WS_W3S) + (size_t)l * 32 * 256 * 512, 512, 512, 512, (size_t)NCHROW * 512 * 2, (size_t)256 * 512 * 2}; pg8::GroupOrder S; S.init(lastl ? 8 : 9, 1, 32, C.G, C.bid, 128);
              EpiSsmY E{WSP(bf16_t, WS_YG)}; pg8::gemm_phase(lds, C.tid, g, S, E); }
            ENDPH(base + 4); }
        if (PHEN(5) && IN(base + 5)) { FRESH();
            if (elem_first) { BODY(14) phase_rwkv_out(C, l, nrt); __syncthreads(); }
            BODY(13) { pg8::Gemm g{WSP(bf16_t, WS_YG), WSP(bf16_t, WS_WGLU), 512, 512, 512, 0, 0}; pg8::GroupOrder S; S.init(nMt, 2, 1, C.G, C.bid);
              EpiGlu E{WSP(bf16_t, WS_YG), CIN(18) + l * 512, WSP(bf16_t, WS_YBR0)}; pg8::gemm_phase(lds, C.tid, g, S, E); }
            __syncthreads();
            if (!elem_first) { BODY(14) phase_rwkv_out(C, l, nrt); }
            ENDPH(base + 5); }
        if (PHEN(6) && IN(base + 6)) { FRESH();
            BODY(15) { pg8::Gemm g{WSP(bf16_t, WS_YBR0), WSP(bf16_t, WS_WBR), 512, 512, 512, YBR_STRIDE, (size_t)1024 * 512 * 2}; pg8::GroupOrder S; S.init(nMt, 4, 3, C.G, C.bid);
            EpiBf16 E{WSP(bf16_t, WS_BR), 1024, (size_t)NT * 1024}; pg8::gemm_phase(lds, C.tid, g, S, E); } ENDPH(base + 6); }
        if (PHEN(7) && IN(base + 7)) { FRESH(); BODY(23) phase_merge_sum(C, nrt); ENDPH(base + 7); }
        if (PHEN(8) && IN(base + 8)) { FRESH();
            BODY(16) { pg8::Gemm g{WSP(bf16_t, WS_MERGED), WSP(bf16_t, WS_WOUT), 1024, 1024, 1024, 0, 0}; pg8::GroupOrder S; S.init(nMt, 4, 1, C.G, C.bid);
            EpiWout E{WSP(bf16_t, WS_XB), WSP(float, WS_MOD) + (size_t)l * 17 * 6144}; pg8::gemm_phase(lds, C.tid, g, S, E); } ENDPH(base + 8); }
        if (PHEN(9) && IN(base + 9)) { FRESH(); BODY(17) phase_norm2(C, l, nrt); BODY(18) phase_conv_moe(C, l); ENDPH(base + 9); }
        if (PHEN(10) && IN(base + 10)) { FRESH(); BODY(19) phase_topk(C, lastl ? 256 : 512); ENDPH(base + 10); }
        if (PHEN(11) && IN(base + 11)) { FRESH();
            BODY(21) { pg8::Gemm g{WSP(bf16_t, WS_XS), WSP(bf16_t, WS_W13), 1024, 1024, 1024, (size_t)EROWS * 1024, (size_t)3072 * 1024};   pg8::GroupOrder S; S.init(lastl ? 16 : EROWS / 256, 12, 16, C.G, C.bid);
            EpiMoe1 E{WSP(unsigned char, WS_HID)}; pg8::gemm_phase<EpiMoe1, pg8::GroupOrder, true>(lds, C.tid, g, S, E); } ENDPH(base + 11); }
        if (PHEN(12) && IN(base + 12)) { FRESH();
            BODY(22) { pg8::Gemm g{WSP(bf16_t, WS_HID), WSP(bf16_t, WS_W2), FF, FF, FF, (size_t)EROWS * FF, (size_t)1024 * FF};   pg8::GroupOrder S; S.init(lastl ? 16 : EROWS / 256, 4, 16, C.G, C.bid);
            EpiMoe2 E{WSP(bf16_t, WS_YBUF), WSP(float, WS_GATE)}; pg8::gemm_phase<EpiMoe2, pg8::GroupOrder, true>(lds, C.tid, g, S, E); } ENDPH(base + 12); }
    }
    if (IN(PH_FINAL)) { FRESH(); phase_final(C); }
#undef IN
#undef ENDPH
#undef SEAM
}

extern "C" void kernel_launch(void* const* d_in, const int* in_sizes, int n_in, void* d_out, int out_size, void* d_ws, size_t ws_size, hipStream_t stream) {
    static int grid = 0;
    if (grid == 0) {
        if (n_in != 44 || ws_size < WS_END) { fprintf(stderr, "kernel_launch: unexpected n_in %d or ws_size %zu (need %zu)\n", n_in, ws_size, (size_t)WS_END); grid = -1; return; }
        int dev = 0, cus = 0, per_cu = 0;
        if (hipGetDevice(&dev) != hipSuccess || hipDeviceGetAttribute(&cus, hipDeviceAttributeMultiprocessorCount, dev) != hipSuccess) { grid = -1; return; }
        if (hipFuncSetAttribute((const void*)trunk_fwd, hipFuncAttributeMaxDynamicSharedMemorySize, LDS_BYTES) != hipSuccess) { fprintf(stderr, "kernel_launch: hipFuncSetAttribute failed\n"); grid = -1; return; }
        if (hipOccupancyMaxActiveBlocksPerMultiprocessor(&per_cu, (const void*)trunk_fwd, NTHREADS, LDS_BYTES) != hipSuccess || per_cu < 1) fprintf(stderr, "kernel_launch: occupancy query says %d\n", per_cu);
        (void)hipGetLastError();
        grid = cus;
    }
    if (grid < 0) return;
    (void)hipMemsetAsync((char*)d_ws + WS_CTL, 0, CTL_BYTES, stream);
    Args a{};
    for (int i = 0; i < 44; ++i) a.in[i] = (const float*)d_in[i];
    a.out = (float*)d_out; a.ws = (unsigned char*)d_ws; a.bmask = 0xffffffffu;
#if MK_PER_PHASE
    for (int ph = 0; ph < NPHASES; ++ph) { a.ph_lo = ph; a.ph_hi = ph + 1; hipLaunchKernelGGL(trunk_fwd, dim3(grid), dim3(NTHREADS), LDS_BYTES, stream, a);
        static const int body_phase[24] = {0, 0, 1, 2, 2, 2, 2, 3, 3, 3, 4, 4, 4, 5, 5, 6, 8, 9, 9, 10, 10, 11, 12, 7};
        bool hit = false; for (int b = 0; b < 24; ++b) if (((PROBE_BODIES >> b) & 1u) && ph >= 1 && ph < PH_FINAL && (ph - 1) % NPH_LAYER == body_phase[b]) hit = true;
        if (hit) { a.bmask = PROBE_BODIES; hipLaunchKernelGGL(trunk_fwd, dim3(grid), dim3(NTHREADS), LDS_BYTES, stream, a); a.bmask = 0xffffffffu; } }
#else
    a.ph_lo = 0; a.ph_hi = NPHASES; hipLaunchKernelGGL(trunk_fwd, dim3(grid), dim3(NTHREADS), LDS_BYTES, stream, a);
#endif
}
```

```cpp
#include <hip/hip_runtime.h>
#include <stdint.h>
#include <stdio.h>

#define LAS __attribute__((address_space(3)))
typedef unsigned short bf16_t;
typedef short bf16x8 __attribute__((ext_vector_type(8)));
typedef float f32x4 __attribute__((ext_vector_type(4)));
typedef float f32x2 __attribute__((ext_vector_type(2)));
typedef unsigned u32x4 __attribute__((ext_vector_type(4)));
typedef unsigned u32x2 __attribute__((ext_vector_type(2)));

constexpr int NB = 16, TL = 2048, TC = 256, DM = 1024, DEPTH = 4;
constexpr int NL = NB * TL;
constexpr int NC = NB * TC;
constexpr int NT = NL + NC;
constexpr int N_IN = 6176, N_INP = 6400;
constexpr int LDP = 5888;
constexpr int PC_MLA = 1920, PC_CKV = 2304, PC_KR = 2560, PC_GATE = 2592;
constexpr int NCHROW = NT / 16;
constexpr int HS = 2048;
constexpr int NE = 16, FF = 1536, EROWS = 4608;
constexpr float NORM_EPS = 1e-6f, GN_EPS = 64e-5f;
constexpr float QSCALE = 0.10206207261596577f * 1.4426950408889634f;

constexpr size_t MiB = 1u << 20;
constexpr size_t WS_CTL = 0, CTL_BYTES = 1 * MiB;
constexpr size_t WS_MOD = 1 * MiB;
constexpr size_t WS_AFF = 3 * MiB;
constexpr size_t WS_SLOT = 6 * MiB;
constexpr size_t WS_IDX = 9 * MiB;
constexpr size_t WS_GATE = 10 * MiB;
constexpr size_t WS_A16 = 11 * MiB;
constexpr size_t WS_WIN = 12 * MiB;
constexpr size_t WS_WLORA = WS_WIN + 13107200;
constexpr size_t WS_WUQ = WS_WLORA + 1966080;
constexpr size_t WS_WUKV = WS_WUQ + 589824;
constexpr size_t WS_WGLU = WS_WUKV + 524288;
constexpr size_t WS_WBR = WS_WGLU + 524288;
constexpr size_t WS_WOUT = WS_WBR + 3145728;
static_assert(WS_WOUT + 2097152 <= 46 * MiB, "small weights");
constexpr size_t WS_GRW = 46 * MiB;
constexpr size_t WS_GV = 48 * MiB;
constexpr size_t WS_RBIAS = 49 * MiB;
constexpr size_t WS_H = 62 * MiB;
constexpr size_t WS_P = 134 * MiB;
constexpr size_t WS_UT = 548 * MiB;
constexpr size_t WS_E = 620 * MiB;
constexpr size_t WS_QRAW = 692 * MiB;
constexpr size_t WS_KVRAW = 746 * MiB;
constexpr size_t WS_Q = 818 * MiB;
constexpr size_t WS_K = 872 * MiB;
constexpr size_t WS_V = 926 * MiB;
constexpr size_t WS_RKVK = 962 * MiB;
constexpr size_t WS_LIN = 1106 * MiB;
constexpr size_t WS_LOUT = 1133 * MiB;
constexpr size_t WS_W1S = 1313 * MiB;
constexpr size_t WS_W3S = 1329 * MiB;
constexpr size_t WS_XB = 1361 * MiB;
constexpr size_t WS_END = 1433 * MiB;
constexpr size_t WS_YBR0 = WS_UT, WS_YBR1 = WS_UT + 36 * MiB;
constexpr size_t WS_YBR2 = WS_E;
constexpr size_t WS_YG = WS_E + 36 * MiB;
constexpr size_t WS_Y2 = WS_QRAW;
constexpr size_t WS_H8 = WS_Q;
constexpr size_t WS_WIN8 = WS_K;
#ifndef WIN_NB16
#define WIN_NB16 12
#endif
constexpr size_t WS_MERGED = WS_Q;
constexpr size_t WS_BR = WS_RKVK;
constexpr size_t WS_W13 = WS_P;
constexpr size_t WS_W2 = WS_P + 96 * MiB;
constexpr size_t WS_XS = WS_P + 144 * MiB;
constexpr size_t WS_HID = WS_P + 288 * MiB;
constexpr size_t WS_YBUF = WS_P + 504 * MiB;
constexpr size_t YBR_STRIDE = (size_t)NT * 512 * 2;
static_assert(WS_YBR1 - WS_YBR0 == 36 * MiB && WS_YBR2 - WS_YBR1 == 36 * MiB && 36 * MiB == YBR_STRIDE, "ybr stride");

constexpr int LDS_BYTES = 147456;
constexpr int NTHREADS = 512;

__device__ __forceinline__ float bflo(unsigned w) { return __uint_as_float(w << 16); }
__device__ __forceinline__ float bfhi(unsigned w) { return __uint_as_float(w & 0xffff0000u); }
__device__ __forceinline__ unsigned pk2(float lo, float hi) { unsigned r; asm volatile("v_cvt_pk_bf16_f32 %0, %1, %2" : "=v"(r) : "v"(lo), "v"(hi)); return r; }
__device__ __forceinline__ float sigmoidf_(float x) { return __builtin_amdgcn_rcpf(1.0f + __expf(-x)); }
__device__ __forceinline__ float siluf_(float x) { return x * __builtin_amdgcn_rcpf(1.0f + __expf(-x)); }
__device__ __forceinline__ float gelu_tanh(float x) { const float z = 0.7978845608f * (x + 0.044715f * x * x * x); const float t = 1.0f - 2.0f * __builtin_amdgcn_rcpf(__expf(2.0f * z) + 1.0f); return 0.5f * x * (1.0f + t); }
template <int CTRL> __device__ __forceinline__ float dppf(float x) { return __builtin_bit_cast(float, __builtin_amdgcn_update_dpp(0, __builtin_bit_cast(int, x), CTRL, 0xf, 0xf, true)); }
__device__ __forceinline__ float red8(float x) { x += dppf<0xB1>(x); x += dppf<0x4E>(x); x += dppf<0x141>(x); return x; }
__device__ __forceinline__ float red16(float x) { x = red8(x); x += dppf<0x140>(x); return x; }
__device__ __forceinline__ float max16(float x) { x = fmaxf(x, dppf<0xB1>(x)); x = fmaxf(x, dppf<0x4E>(x)); x = fmaxf(x, dppf<0x141>(x)); x = fmaxf(x, dppf<0x140>(x)); return x; }
__device__ __forceinline__ float red64(float x) { x = red16(x); x += __shfl_xor(x, 16); x += __shfl_xor(x, 32); return x; }
__device__ __forceinline__ unsigned pk4_fp8(float a, float b, float c, float d) { a = __builtin_amdgcn_fmed3f(a, -448.f, 448.f); b = __builtin_amdgcn_fmed3f(b, -448.f, 448.f); c = __builtin_amdgcn_fmed3f(c, -448.f, 448.f); d = __builtin_amdgcn_fmed3f(d, -448.f, 448.f);
    int p = __builtin_amdgcn_cvt_pk_fp8_f32(a, b, 0, false); p = __builtin_amdgcn_cvt_pk_fp8_f32(c, d, p, true); return (unsigned)p; }
constexpr float F8_SG = 16.f;
constexpr float F8_SW = 1024.f, F8_SX = 16.f, F8_SH = 8.f;
__device__ __forceinline__ void unpack8(const u32x4 w, float (&f)[8]) { f[0] = bflo(w.x); f[1] = bfhi(w.x); f[2] = bflo(w.y); f[3] = bfhi(w.y); f[4] = bflo(w.z); f[5] = bfhi(w.z); f[6] = bflo(w.w); f[7] = bfhi(w.w); }
__device__ __forceinline__ u32x4 pack8(const float (&f)[8]) { u32x4 w; w.x = pk2(f[0], f[1]); w.y = pk2(f[2], f[3]); w.z = pk2(f[4], f[5]); w.w = pk2(f[6], f[7]); return w; }

#define XB_TMO      128
#define XB_XCNT(j)  (256  + 64 * (j))
#define XB_XSUB(j)  (1280 + 64 * (j))
#define XB_XGEN(j)  (2304 + 64 * (j))
#define XB_TOP      3328
#define XB_TOPGEN   3392
#define XCD_BAR_WORDS 3456
#define XB_SPIN_CAP (1u << 18)
__device__ __forceinline__ unsigned xb_ld(unsigned* p)              { return __hip_atomic_load(p, __ATOMIC_RELAXED, __HIP_MEMORY_SCOPE_AGENT); }
__device__ __forceinline__ unsigned xb_add(unsigned* p, unsigned v) { return __hip_atomic_fetch_add(p, v, __ATOMIC_RELAXED, __HIP_MEMORY_SCOPE_AGENT); }
__device__ __forceinline__ unsigned xb_xcc_id() { return (unsigned)__builtin_amdgcn_s_getreg((3 << 11) | 20) & 0xFu; }
#define XB_SPIN(cond, bar) do { unsigned _sp = 0; while (cond) { __builtin_amdgcn_s_sleep(1); \
    if ((++_sp & 255u) == 0u) { if (xb_ld(&(bar)[XB_TMO])) break; if (_sp > XB_SPIN_CAP) { atomicAdd(&(bar)[XB_TMO], 1u); break; } } } } while (0)
struct XcdBarrier { unsigned* bar; unsigned x; volatile LAS unsigned* st; };
__device__ __forceinline__ XcdBarrier xcd_barrier_post(unsigned* bar, volatile LAS unsigned* st) {
    XcdBarrier b; b.bar = bar; b.x = xb_xcc_id(); b.st = st;
    if (threadIdx.x == 0) (void)xb_add(&bar[XB_XCNT(b.x)], 1u);
    return b;
}
__device__ __forceinline__ void xcd_barrier_complete(unsigned* bar, unsigned x, unsigned& nloc, unsigned& nx) {
    const unsigned G = gridDim.x * gridDim.y * gridDim.z;
    unsigned sum, cnt, mine, sp = 0u;
    for (;;) {
        sum = 0u; cnt = 0u; mine = 0u;
#pragma unroll
        for (unsigned j = 0; j < 16; ++j) { const unsigned c = xb_ld(&bar[XB_XCNT(j)]); sum += c; cnt += (c > 0u) ? 1u : 0u; mine = (j == x) ? c : mine; }
        if (sum == G) break;
        __builtin_amdgcn_s_sleep(1);
        if ((++sp & 255u) == 0u) { if (xb_ld(&bar[XB_TMO])) break; if (sp > XB_SPIN_CAP) { atomicAdd(&bar[XB_TMO], 1u); break; } }
    }
    nloc = mine > 0u ? mine : 1u; nx = cnt > 0u ? cnt : 1u;
}
__device__ __forceinline__ void xcd_barrier(const XcdBarrier& b) {
    asm volatile("s_waitcnt vmcnt(0)" ::: "memory");
    __syncthreads();
    if (threadIdx.x == 0) {
        unsigned* bar = b.bar;
        __builtin_amdgcn_s_waitcnt(0);
        unsigned nloc = b.st[0], nx = b.st[1];
        if (nloc == 0u) { xcd_barrier_complete(bar, b.x, nloc, nx); b.st[0] = nloc; b.st[1] = nx; }
        const unsigned old = xb_add(&bar[XB_XSUB(b.x)], 1u);
        const unsigned gen = old / nloc;
        if (old + 1u == (gen + 1u) * nloc) {
            __builtin_amdgcn_fence(__ATOMIC_RELEASE, "agent");
            asm volatile("s_waitcnt vmcnt(0)" ::: "memory");
            const unsigned og = xb_add(&bar[XB_TOP], 1u);
            const unsigned tg = og / nx;
            if (og + 1u == (tg + 1u) * nx) xb_add(&bar[XB_TOPGEN], 1u);
            else XB_SPIN(xb_ld(&bar[XB_TOPGEN]) == tg, bar);
            __builtin_amdgcn_fence(__ATOMIC_ACQUIRE, "agent");
            xb_add(&bar[XB_XGEN(b.x)], 1u);
            asm volatile("s_waitcnt vmcnt(0)" ::: "memory");
        } else {
            XB_SPIN(xb_ld(&bar[XB_XGEN(b.x)]) == gen, bar);
            __builtin_amdgcn_fence(__ATOMIC_ACQUIRE, "agent");
            asm volatile("s_waitcnt vmcnt(0)" ::: "memory");
        }
    }
    __syncthreads();
}

namespace pg8 {
constexpr int BM = 256, BK = 64, HALF = 128, HTB = HALF * BK * 2, STAGE_BYTES = 8 * HTB, NXCD = 8, WGM = 8;
__device__ __forceinline__ int lds_byte(int r, int c) { const int st = (r >> 4) * 2 + (c >> 5), rr = r & 15, cc = c & 31, ob = rr * 64 + cc * 2; return st * 1024 + (ob ^ (((ob >> 9) & 1) << 5)); }
__device__ __forceinline__ void stage_rc(int b, int& R, int& C) { const int st = b / 1024, sb = b % 1024, swz = sb ^ (((sb >> 9) & 1) << 5); R = (st >> 1) * 16 + swz / 64; C = (st & 1) * 32 + (swz % 64) / 2; }
__device__ __forceinline__ int perm32(int rho) { const int n = rho >> 4, i = rho & 15; return 8 * (i >> 2) + 4 * n + (i & 3); }
struct Unit { int pm, pn, g; };
struct Gemm { const bf16_t* A; const bf16_t* Bt; int lda, ldb, K; size_t gsA, gsB; };

struct GroupOrder {
    int nM, nN, per, nwg, G, c;
    __device__ void init(int nM_, int nN_, int nG, int G_, int c_, int rot = 0) { nM = nM_; nN = nN_; per = nM * nN; nwg = per * nG; G = G_; c = (c_ + G_ - (rot % G_)) % G_; }
    __device__ bool next(int i, Unit& u) const {
        const long L = (long)i * G + c; if (L >= nwg) return false;
        int wgid = (int)L; { const int q = nwg / NXCD, r = nwg % NXCD, xcd = wgid % NXCD, off = wgid / NXCD; wgid = (xcd < r ? xcd * (q + 1) : r * (q + 1) + (xcd - r) * q) + off; }
        u.g = wgid / per; const int w = wgid - u.g * per;
        const int nig = WGM * nN, gid = w / nig, fm = gid * WGM, gsz = (nM - fm) < WGM ? (nM - fm) : WGM;
        u.pm = fm + ((w % nig) % gsz); u.pn = (w % nig) / gsz; return true;
    }
};
struct MergeOrder {
    int nM, nN, ntile, G, c;
    __device__ void init(int nM_, int nN_, int G_, int c_) { nM = nM_; nN = nN_; ntile = nM * nN; G = G_; c = c_; }
    __device__ bool next(int i, Unit& u) const {
        const int t = (i / 3) * G + c; if (t >= ntile) return false;
        u.g = i % 3; u.pm = t / nN; u.pn = t % nN; return true;
    }
};

typedef int v8i32 __attribute__((ext_vector_type(8)));
__device__ __forceinline__ v8i32 cat8(const bf16x8& a, const bf16x8& b) { const u32x4 x = __builtin_bit_cast(u32x4, a), y = __builtin_bit_cast(u32x4, b); return (v8i32){(int)x.x, (int)x.y, (int)x.z, (int)x.w, (int)y.x, (int)y.y, (int)y.z, (int)y.w}; }
template <class Epi, class Sched, bool FP8 = false>
__device__ __forceinline__ void gemm_phase(LAS unsigned char* lds, const int tid, const Gemm g, const Sched& S, const Epi& E) {
    const int wid = __builtin_amdgcn_readfirstlane(tid >> 6), lane = tid & 63, wr = wid >> 2, wc = wid & 3, fr = lane & 15, fq = lane >> 4;
    constexpr int EB = FP8 ? 1 : 2;
    const int K = g.K, nt = (K * EB) / (BK * 2);
    unsigned voffA, voffB;
    { int R, C; stage_rc(tid * 16, R, C); const int Rb = Epi::PERM ? ((R & ~31) + perm32(R & 31)) : R; voffA = (unsigned)(R * g.lda * EB + C * 2); voffB = (unsigned)(Rb * g.ldb * EB + C * 2); }
    const size_t r64voffA = (size_t)64 * g.lda * EB, r64voffB = (size_t)64 * g.ldb * EB;
    const size_t kstep = (size_t)(BK * 2);
    const size_t hstepA = (size_t)HALF * g.lda * EB, hstepB = (size_t)HALF * g.ldb * EB;
    const size_t tstepA = 2 * hstepA, tstepB = 2 * hstepB;
    const unsigned ldsw = (unsigned)wid * 1024u;
    const int aoff = lds_byte(wr * 64 + fr, fq * 8), boff = lds_byte(wc * 32 + fr, fq * 8);
#define PG8_SA(b, h) (((b) * 2 + (h)) * HTB)
#define PG8_SB(b, h) ((4 + (b) * 2 + (h)) * HTB)
#define PG8_STAGE(bufoff, gbase, voff) do { _Pragma("unroll") for (int _i = 0; _i < 2; ++_i) \
        __builtin_amdgcn_global_load_lds((const unsigned*)((const char*)(gbase) + (size_t)_i * r64##voff + (voff)), (LAS unsigned*)(lds + (bufoff) + ldsw + _i * 8192), 16, 0, 0); } while (0)
#define PG8_LD8(dst, off) do { typedef int v4i32_ __attribute__((ext_vector_type(4))); const v4i32_ lo_ = *(const LAS v4i32_*)(lds + (off)), hi_ = *(const LAS v4i32_*)(lds + (off) + 1024); (dst) = __builtin_shufflevector(lo_, hi_, 0, 1, 2, 3, 4, 5, 6, 7); } while (0)
#define PG8_LDA(dst, b, h) do { if constexpr (FP8) { _Pragma("unroll") for (int m = 0; m < 4; ++m) PG8_LD8(dst##8[m], PG8_SA(b, h) + aoff + m * 2048); } \
      else { _Pragma("unroll") for (int m = 0; m < 4; ++m) _Pragma("unroll") for (int k = 0; k < 2; ++k) dst[m][k] = *(const LAS bf16x8*)(lds + PG8_SA(b, h) + aoff + m * 2048 + k * 1024); } } while (0)
#define PG8_LDB(dst, b, h) do { if constexpr (FP8) { _Pragma("unroll") for (int n = 0; n < 2; ++n) PG8_LD8(dst##8[n], PG8_SB(b, h) + boff + n * 2048); } \
      else { _Pragma("unroll") for (int n = 0; n < 2; ++n) _Pragma("unroll") for (int k = 0; k < 2; ++k) dst[n][k] = *(const LAS bf16x8*)(lds + PG8_SB(b, h) + boff + n * 2048 + k * 1024); } } while (0)
#define PG8_MMA(ai, bj, At, Bt) do { __builtin_amdgcn_s_setprio(1); if constexpr (FP8) { _Pragma("unroll") for (int m = 0; m < 4; ++m) _Pragma("unroll") for (int n = 0; n < 2; ++n) \
        asm("v_mfma_scale_f32_16x16x128_f8f6f4 %0, %1, %2, %0, %3, %3 op_sel_hi:[0,0,0]" : "+v"(acc[ai][bj][m][n]) : "v"(Bt##8[n]), "v"(At##8[m]), "v"(f8scale));     } \
      else { _Pragma("unroll") for (int m = 0; m < 4; ++m) _Pragma("unroll") for (int n = 0; n < 2; ++n) _Pragma("unroll") for (int k = 0; k < 2; ++k) \
        acc[ai][bj][m][n] = __builtin_amdgcn_mfma_f32_16x16x32_bf16(Bt[n][k], At[m][k], acc[ai][bj][m][n], 0, 0, 0); } __builtin_amdgcn_s_setprio(0); } while (0)
#define PG8_WAIT_V(n) asm volatile("s_waitcnt vmcnt(" #n ")" ::: "memory")
#define PG8_WAIT_L(n) asm volatile("s_waitcnt lgkmcnt(" #n ")" ::: "memory")
#define PG8_BAR __builtin_amdgcn_s_barrier()
#define PG8_SCHED __builtin_amdgcn_sched_barrier(0)
    Unit cur, nxt; int ui = 0;
    if (!S.next(0, cur)) return;
    f32x4 acc[2][2][4][2];
#pragma unroll
    for (int a = 0; a < 2; ++a)
#pragma unroll
        for (int b = 0; b < 2; ++b)
#pragma unroll
            for (int m = 0; m < 4; ++m)
#pragma unroll
                for (int n = 0; n < 2; ++n) acc[a][b][m][n] = (f32x4){0.f, 0.f, 0.f, 0.f};
    bf16x8 At[4][2], B0[2][2], B1[2][2];
    v8i32 At8[4], B08[2], B18[2];
    const int f8scale = 0x7f7f7f7f;
    const char* cA = (const char*)g.A + (size_t)cur.g * g.gsA + (size_t)cur.pm * tstepA; const char* cB = (const char*)g.Bt + (size_t)cur.g * g.gsB + (size_t)cur.pn * tstepB;
    PG8_STAGE(PG8_SB(0, 0), cB, voffB); PG8_STAGE(PG8_SA(0, 0), cA, voffA); PG8_STAGE(PG8_SB(0, 1), cB + hstepB, voffB); PG8_STAGE(PG8_SA(0, 1), cA + hstepA, voffA);
    if (wr == 1) PG8_BAR;
    PG8_WAIT_V(4); PG8_BAR;
    PG8_STAGE(PG8_SB(1, 0), cB + kstep, voffB); PG8_STAGE(PG8_SA(1, 0), cA + kstep, voffA); PG8_STAGE(PG8_SB(1, 1), cB + hstepB + kstep, voffB);
    PG8_WAIT_V(6); PG8_BAR;
    for (;;) {
        const bool has_next = S.next(ui + 1, nxt);
        const char* nA = has_next ? (const char*)g.A + (size_t)nxt.g * g.gsA + (size_t)nxt.pm * tstepA : cA; const char* nB = has_next ? (const char*)g.Bt + (size_t)nxt.g * g.gsB + (size_t)nxt.pn * tstepB : cB;
#pragma nounroll
        for (int t = 0; t < nt; t += 2) {
            const bool last = (t == nt - 2);
            const char* a1 = cA + (size_t)(t + 1) * kstep;
            const char* a2 = last ? nA : cA + (size_t)(t + 2) * kstep; const char* b2 = last ? nB : cB + (size_t)(t + 2) * kstep;
            const char* a3 = a2 + kstep; const char* b3 = b2 + kstep;
            PG8_LDB(B0, 0, 0); PG8_SCHED; PG8_LDA(At, 0, 0); PG8_STAGE(PG8_SA(1, 1), a1 + hstepA, voffA);
            PG8_WAIT_L(8); PG8_BAR; PG8_WAIT_L(0); PG8_MMA(0, 0, At, B0); PG8_BAR; PG8_SCHED;
            PG8_LDB(B1, 0, 1); PG8_STAGE(PG8_SB(0, 0), b2, voffB);
            PG8_BAR; PG8_WAIT_L(0); PG8_MMA(0, 1, At, B1); PG8_BAR;
            PG8_LDA(At, 0, 1); PG8_STAGE(PG8_SA(0, 0), a2, voffA);
            PG8_BAR; PG8_WAIT_L(0); PG8_MMA(1, 0, At, B0); PG8_BAR; PG8_SCHED;
            PG8_STAGE(PG8_SB(0, 1), b2 + hstepB, voffB);
            PG8_WAIT_V(6); PG8_BAR; PG8_MMA(1, 1, At, B1); PG8_BAR;
            PG8_LDB(B0, 1, 0); PG8_SCHED; PG8_LDA(At, 1, 0); PG8_STAGE(PG8_SA(0, 1), a2 + hstepA, voffA);
            PG8_WAIT_L(8); PG8_BAR; PG8_WAIT_L(0); PG8_MMA(0, 0, At, B0); PG8_BAR; PG8_SCHED;
            PG8_LDB(B1, 1, 1); PG8_STAGE(PG8_SB(1, 0), b3, voffB);
            PG8_BAR; PG8_WAIT_L(0); PG8_MMA(0, 1, At, B1); PG8_BAR;
            PG8_LDA(At, 1, 1); PG8_STAGE(PG8_SA(1, 0), a3, voffA);
            PG8_BAR; PG8_WAIT_L(0); PG8_MMA(1, 0, At, B0); PG8_BAR; PG8_SCHED;
            PG8_STAGE(PG8_SB(1, 1), b3 + hstepB, voffB);
            PG8_WAIT_V(6); PG8_BAR; PG8_MMA(1, 1, At, B1); PG8_BAR;
        }
        E(acc, cur, wr, wc, fr, fq);
        if (!has_next) break;
#pragma unroll
        for (int a = 0; a < 2; ++a)
#pragma unroll
            for (int b = 0; b < 2; ++b)
#pragma unroll
                for (int m = 0; m < 4; ++m)
#pragma unroll
                    for (int n = 0; n < 2; ++n) acc[a][b][m][n] = (f32x4){0.f, 0.f, 0.f, 0.f};
        cur = nxt; cA = nA; cB = nB; ++ui;
    }
    PG8_WAIT_V(0);
    if (wr == 0) PG8_BAR;
    PG8_BAR;
#undef PG8_SA
#undef PG8_SB
#undef PG8_STAGE
#undef PG8_LD8
#undef PG8_LDA
#undef PG8_LDB
#undef PG8_MMA
#undef PG8_WAIT_V
#undef PG8_WAIT_L
#undef PG8_BAR
#undef PG8_SCHED
}
}
using pg8::Unit;
typedef f32x4 Acc[2][2][4][2];
#define EPI_ROWS(...) _Pragma("unroll") for (int ai = 0; ai < 2; ++ai) _Pragma("unroll") for (int m = 0; m < 4; ++m) { const int row = row0 + ai * 128 + m * 16; __VA_ARGS__ }

__device__ __forceinline__ u32x4 pack_acc8(const f32x4& a, const f32x4& b) { u32x4 w; w.x = pk2(a[0], a[1]); w.y = pk2(a[2], a[3]); w.z = pk2(b[0], b[1]); w.w = pk2(b[2], b[3]); return w; }

struct EpiWin { static constexpr bool PERM = true; bf16_t* P; bf16_t* UT; int pn0; float s;
    __device__ __forceinline__ void operator()(const Acc& acc, const Unit& u, int wr, int wc, int fr, int fq) const {
        const int row0 = u.pm * 256 + wr * 64 + fr;
        EPI_ROWS(
_Pragma("unroll")
            for (int bj = 0; bj < 2; ++bj) { const int col0 = (u.pn + pn0) * 256 + bj * 128 + wc * 32 + 8 * fq;
                if (col0 >= 512 + PC_GATE) { const f32x4 a0 = acc[ai][bj][m][0] * (s * F8_SG), a1 = acc[ai][bj][m][1] * (s * F8_SG);
                    *(u32x2*)((unsigned char*)(P + (size_t)row * LDP + PC_GATE) + (col0 - 512 - PC_GATE)) = (u32x2){pk4_fp8(a0[0], a0[1], a0[2], a0[3]), pk4_fp8(a1[0], a1[1], a1[2], a1[3])}; }
                else { const u32x4 w = pack_acc8(acc[ai][bj][m][0] * s, acc[ai][bj][m][1] * s);
                    bf16_t* dst = (u.pn + pn0 < 2) ? UT + ((size_t)(col0 >> 4) * NCHROW + (row >> 4)) * 512 + (row & 15) * 16 + (col0 & 15) : P + (size_t)row * LDP + (col0 - 512);
                    *(u32x4*)dst = w; } } )
    } };
struct EpiBf16 { static constexpr bool PERM = true; bf16_t* O; int ldc; size_t gstride;
    __device__ __forceinline__ void operator()(const Acc& acc, const Unit& u, int wr, int wc, int fr, int fq) const {
        const int row0 = u.pm * 256 + wr * 64 + fr;
        EPI_ROWS(
_Pragma("unroll")
            for (int bj = 0; bj < 2; ++bj) { const int col0 = u.pn * 256 + bj * 128 + wc * 32 + 8 * fq; *(u32x4*)(O + (size_t)u.g * gstride + (size_t)row * ldc + col0) = pack_acc8(acc[ai][bj][m][0], acc[ai][bj][m][1]); } )
    } };
struct EpiSsmE { static constexpr bool PERM = false; float* Eo;
    __device__ __forceinline__ void operator()(const Acc& acc, const Unit& u, int wr, int wc, int fr, int fq) const {
        const int row0 = u.pm * 256 + wr * 64 + fr; float* base = Eo + (size_t)u.g * NCHROW * 256;
        EPI_ROWS(
_Pragma("unroll")
            for (int bj = 0; bj < 2; ++bj)
_Pragma("unroll")
                for (int n = 0; n < 2; ++n) *(f32x4*)(base + (size_t)row * 256 + bj * 128 + wc * 32 + n * 16 + 4 * fq) = acc[ai][bj][m][n]; )
    } };
struct EpiLora { static constexpr bool PERM = true; bf16_t* O; const float* w0; const float* a0;
    __device__ __forceinline__ void operator()(const Acc& acc, const Unit& u, int wr, int wc, int fr, int fq) const {
        const int row0 = u.pm * 256 + wr * 64 + fr; const int reg = u.pn >> 1, cb = u.g * 512 + (u.pn & 1) * 256;
        const float scl = reg == 0 ? 0.6065306597f : 1.0f; const float* bsrc = (reg == 0 ? w0 : a0) + cb; bf16_t* ob = O + reg * 1024 + cb;
#pragma unroll
        for (int bj = 0; bj < 2; ++bj) { const int cl = bj * 128 + wc * 32 + 8 * fq;
            const f32x4 b0 = *(const f32x4*)(bsrc + cl), b1 = *(const f32x4*)(bsrc + cl + 4);
            EPI_ROWS( const f32x4 x0 = acc[ai][bj][m][0] + b0; const f32x4 x1 = acc[ai][bj][m][1] + b1; float v[8];
_Pragma("unroll")
                for (int j = 0; j < 4; ++j) { v[j] = scl * sigmoidf_(x0[j]); v[4 + j] = scl * sigmoidf_(x1[j]); }
                *(u32x4*)(ob + (size_t)row * 2560 + cl) = pack8(v); )
        }
    } };
struct EpiSsmY { static constexpr bool PERM = true; bf16_t* YG;
    __device__ __forceinline__ void operator()(const Acc& acc, const Unit& u, int wr, int wc, int fr, int fq) const {
        const int row0 = u.pm * 256 + wr * 64 + fr;
        EPI_ROWS(
_Pragma("unroll")
            for (int bj = 0; bj < 2; ++bj) { const int n0 = bj * 128 + wc * 32 + 8 * fq; const int tok = row * 16 + (n0 >> 4); float v[8];
_Pragma("unroll")
                for (int j = 0; j < 8; ++j) v[j] = gelu_tanh(j < 4 ? acc[ai][bj][m][0][j & 3] : acc[ai][bj][m][1][j & 3]);
                *(u32x4*)(YG + (size_t)tok * 512 + u.g * 16 + (n0 & 15)) = pack8(v); } )
    } };
struct EpiGlu { static constexpr bool PERM = true; const bf16_t* YG; const float* bias; bf16_t* O;
    __device__ __forceinline__ void operator()(const Acc& acc, const Unit& u, int wr, int wc, int fr, int fq) const {
        const int row0 = u.pm * 256 + wr * 64 + fr;
_Pragma("unroll")
        for (int bj = 0; bj < 2; ++bj) { const int col0 = u.pn * 256 + bj * 128 + wc * 32 + 8 * fq; float b[8];
_Pragma("unroll")
            for (int j = 0; j < 8; ++j) b[j] = bias[col0 + j];
            EPI_ROWS( float y[8], v[8]; unpack8(*(const u32x4*)(YG + (size_t)row * 512 + col0), y);
_Pragma("unroll")
                for (int j = 0; j < 8; ++j) v[j] = y[j] * sigmoidf_((j < 4 ? acc[ai][bj][m][0][j & 3] : acc[ai][bj][m][1][j & 3]) + b[j]);
                *(u32x4*)(O + (size_t)row * 512 + col0) = pack8(v); )
        }
    } };
struct EpiWout { static constexpr bool PERM = true; bf16_t* XB; const float* mod;
    __device__ __forceinline__ void operator()(const Acc& acc, const Unit& u, int wr, int wc, int fr, int fq) const {
        const int row0 = u.pm * 256 + wr * 64 + fr; const int mrow = u.pm < NL / 256 ? (u.pm >> 3) : 16; const float* gv = mod + (size_t)mrow * 6144 + 2 * 1024;
_Pragma("unroll")
        for (int bj = 0; bj < 2; ++bj) { const int col0 = u.pn * 256 + bj * 128 + wc * 32 + 8 * fq; const f32x4 g0 = *(const f32x4*)(gv + col0), g1 = *(const f32x4*)(gv + col0 + 4);
            EPI_ROWS( bf16_t* xp = XB + (size_t)row * 1024 + col0; float xv[8]; unpack8(*(const u32x4*)xp, xv); const f32x4 a0 = acc[ai][bj][m][0] * g0, a1 = acc[ai][bj][m][1] * g1;
_Pragma("unroll")
                for (int j = 0; j < 4; ++j) { xv[j] += a0[j]; xv[4 + j] += a1[j]; }
                *(u32x4*)xp = pack8(xv); ) }
    } };
struct EpiMoe1 { static constexpr bool PERM = true; unsigned char* HID;
    __device__ __forceinline__ void operator()(const Acc& acc, const Unit& u, int wr, int wc, int fr, int fq) const {
        const int row0 = u.pm * 256 + wr * 64 + fr; unsigned char* base = HID + (size_t)u.g * EROWS * HS; constexpr float S1 = 1.0f / (F8_SX * F8_SW);
        EPI_ROWS( float v[8];
_Pragma("unroll")
            for (int j = 0; j < 8; ++j) { const float a = (j < 4 ? acc[ai][0][m][0][j & 3] : acc[ai][0][m][1][j & 3]) * S1; const float b = (j < 4 ? acc[ai][1][m][0][j & 3] : acc[ai][1][m][1][j & 3]) * S1; v[j] = siluf_(a) * b * F8_SH; }
            *(u32x2*)(base + (size_t)row * HS + u.pn * 128 + wc * 32 + 8 * fq) = (u32x2){pk4_fp8(v[0], v[1], v[2], v[3]), pk4_fp8(v[4], v[5], v[6], v[7])}; __builtin_amdgcn_sched_barrier(0); )
    } };
struct EpiMoe2 { static constexpr bool PERM = true; bf16_t* Y; const float* gate;
    __device__ __forceinline__ void operator()(const Acc& acc, const Unit& u, int wr, int wc, int fr, int fq) const {
        const int row0 = u.pm * 256 + wr * 64 + fr; bf16_t* base = Y + (size_t)u.g * EROWS * 1024; const float* gt = gate + (size_t)u.g * EROWS;
        EPI_ROWS( const float gv = gt[row] * (1.0f / (F8_SH * F8_SW));
_Pragma("unroll")
            for (int bj = 0; bj < 2; ++bj) { const int col0 = u.pn * 256 + bj * 128 + wc * 32 + 8 * fq; float v[8];
_Pragma("unroll")
                for (int j = 0; j < 8; ++j) v[j] = gv * (j < 4 ? acc[ai][bj][m][0][j & 3] : acc[ai][bj][m][1][j & 3]);
                *(u32x4*)(base + (size_t)row * 1024 + col0) = pack8(v); } )
    } };

struct Args { const float* in[44]; float* out; unsigned char* ws; int ph_lo, ph_hi; unsigned bmask; int pad; };
struct Ctx {
    const __attribute__((address_space(4))) Args* A; float* out; unsigned char* ws; LAS unsigned char* lds; int tid, lane, wave, G, bid;
};
#define GAS __attribute__((address_space(1)))
#define WSP(T, off) ((T*)(C.ws + (off)))
#define CIN(i) ({ const GAS float* p__ = (const GAS float*)C.A->in[i]; asm volatile("" : "+s"(p__)); (const float*)p__; })

__device__ __forceinline__ void phase_ada(const Ctx& C) {
    LAS float* sck = (LAS float*)C.lds;
    LAS float* red = (LAS float*)(C.lds + 81920);
    const float* c = CIN(1); const float* cc = CIN(3); const float* ada_w = CIN(4); const float* ada_b = CIN(5);
    float* MOD = WSP(float, WS_MOD);
    for (int idx = C.tid; idx < 17 * 1024; idx += NTHREADS) { const int m = idx >> 10, k = idx & 1023; const float v = m < 16 ? c[m * 1024 + k] : cc[k]; sck[k * 20 + m] = siluf_(v); }
    __syncthreads();
    const int cl = C.lane & 31, kh = C.lane >> 5;
    for (int u = C.bid; u < 4 * 192; u += C.G) {
        const int l = u / 192, n0 = (u % 192) * 32;
        float acc[17];
#pragma unroll
        for (int m = 0; m < 17; ++m) acc[m] = 0.f;
        const int kb = C.wave * 128 + kh * 64;
        const float* wp = ada_w + ((size_t)l * 1024 + kb) * 6144 + n0 + cl;
#pragma unroll 1
        for (int k0 = 0; k0 < 64; k0 += 16) { float a[16];
#pragma unroll
            for (int q = 0; q < 16; ++q) a[q] = wp[(size_t)(k0 + q) * 6144];
#pragma unroll
            for (int q = 0; q < 16; ++q) { const LAS float* s = sck + (kb + k0 + q) * 20;
                const f32x4 s0 = *(const LAS f32x4*)s, s1 = *(const LAS f32x4*)(s + 4), s2 = *(const LAS f32x4*)(s + 8), s3 = *(const LAS f32x4*)(s + 12); const float s4 = s[16];
#pragma unroll
                for (int j = 0; j < 4; ++j) { acc[j] += s0[j] * a[q]; acc[4 + j] += s1[j] * a[q]; acc[8 + j] += s2[j] * a[q]; acc[12 + j] += s3[j] * a[q]; }
                acc[16] += s4 * a[q]; } }
#pragma unroll
        for (int m = 0; m < 17; ++m) { acc[m] += __shfl_xor(acc[m], 32); if (kh == 0) red[(C.wave * 17 + m) * 32 + cl] = acc[m]; }
        __syncthreads();
        for (int o = C.tid; o < 17 * 32; o += NTHREADS) { const int m = o >> 5, n = o & 31; float s = ada_b[l * 6144 + n0 + n];
#pragma unroll
            for (int w = 0; w < 8; ++w) s += red[(w * 17 + m) * 32 + n];
            MOD[((size_t)l * 17 + m) * 6144 + n0 + n] = s; }
        __syncthreads();
    }
}

__device__ __forceinline__ void conv_tile(const Ctx& C, const float* src, int src_ld, bf16_t* dst, int dst_ld, int n_valid, const float* kgain) {
    LAS float* tile = (LAS float*)C.lds + C.wave * (64 * 65);
    const int r4 = C.lane >> 4, c4 = (C.lane & 15) * 4;
    f32x4 v[16];
#pragma unroll
    for (int i = 0; i < 16; ++i) { v[i] = (f32x4){0.f, 0.f, 0.f, 0.f}; if (src && c4 < n_valid) v[i] = *(const f32x4*)(src + (size_t)(i * 4 + r4) * src_ld + c4); }
    if (kgain) {
#pragma unroll
        for (int i = 0; i < 16; ++i) v[i] *= kgain[i * 4 + r4]; }
#pragma unroll
    for (int i = 0; i < 16; ++i) { LAS float* t = tile + (i * 4 + r4) * 65 + c4; t[0] = v[i][0]; t[1] = v[i][1]; t[2] = v[i][2]; t[3] = v[i][3]; }
    asm volatile("s_waitcnt lgkmcnt(0)" ::: "memory");
    const int nr = C.lane >> 3, ks = (C.lane & 7) * 8;
#pragma unroll
    for (int i = 0; i < 8; ++i) { const int n = i * 8 + nr; float o[8];
#pragma unroll
        for (int j = 0; j < 8; ++j) o[j] = tile[(ks + j) * 65 + n];
        *(u32x4*)(dst + (size_t)n * dst_ld + ks) = pack8(o); }
    asm volatile("s_waitcnt lgkmcnt(0)" ::: "memory");
}

__device__ __forceinline__ void conv_tile_fp8(const Ctx& C, const float* src, int src_ld, unsigned char* dst, int dst_ld, int n_valid = 64) {
    LAS float* tile = (LAS float*)C.lds + C.wave * (64 * 65);
    const int r4 = C.lane >> 4, c4 = (C.lane & 15) * 4;
    f32x4 v[16];
#pragma unroll
    for (int i = 0; i < 16; ++i) { v[i] = (f32x4){0.f, 0.f, 0.f, 0.f}; if (src && c4 < n_valid) v[i] = *(const f32x4*)(src + (size_t)(i * 4 + r4) * src_ld + c4); }
#pragma unroll
    for (int i = 0; i < 16; ++i) { LAS float* t = tile + (i * 4 + r4) * 65 + c4; t[0] = v[i][0] * F8_SW; t[1] = v[i][1] * F8_SW; t[2] = v[i][2] * F8_SW; t[3] = v[i][3] * F8_SW; }
    asm volatile("s_waitcnt lgkmcnt(0)" ::: "memory");
    const int nr = C.lane >> 3, ks = (C.lane & 7) * 8;
#pragma unroll
    for (int i = 0; i < 8; ++i) { const int n = i * 8 + nr; float o[8];
#pragma unroll
        for (int j = 0; j < 8; ++j) o[j] = tile[(ks + j) * 65 + n];
        *(u32x2*)(dst + (size_t)n * dst_ld + ks) = (u32x2){pk4_fp8(o[0], o[1], o[2], o[3]), pk4_fp8(o[4], o[5], o[6], o[7])}; }
    asm volatile("s_waitcnt lgkmcnt(0)" ::: "memory");
}

__device__ __forceinline__ void phase_conv_small(const Ctx& C, int l) {
    for (int t = C.bid * 8 + C.wave; t < 2680; t += C.G * 8) {
        if (t < 1600) { const int nt = t >> 4, kt = t & 15; const float* w = CIN(8) + (size_t)l * 1024 * N_IN;
            if (nt < WIN_NB16 * 4) conv_tile(C, w + (size_t)kt * 64 * N_IN + nt * 64, N_IN, WSP(bf16_t, WS_WIN) + (size_t)nt * 64 * 1024 + kt * 64, 1024, 64, nullptr);
            else conv_tile_fp8(C, nt <= 96 ? w + (size_t)kt * 64 * N_IN + nt * 64 : nullptr, N_IN, WSP(unsigned char, WS_WIN8) + (size_t)nt * 64 * 1024 + kt * 64, 1024, nt < 96 ? 64 : 32); }
        else if (t < 1840) { const int q = t - 1600;
            if (q < 64) { const int j = q >> 5, r = q & 31, nt = r >> 1, kt = r & 1; const int n0 = nt * 64; const float* src = nullptr;
                if (n0 < 512) { if (kt == 0) src = CIN(21) + ((size_t)l * 2 + j) * 64 * 512 + n0; } else { if (kt == 1) src = CIN(23) + ((size_t)l * 2 + j) * 64 * 512 + (n0 - 512); }
                conv_tile(C, src, 512, WSP(bf16_t, WS_WLORA) + ((size_t)j * 1024 + n0) * 128 + kt * 64, 128, 64, nullptr); }
            else if (q < 80) { const int r = q - 64, nt = r >> 1, kt = r & 1;
                conv_tile(C, CIN(24) + ((size_t)l * 128 + kt * 64) * 512 + nt * 64, 512, WSP(bf16_t, WS_WLORA) + (size_t)2 * 1024 * 128 + (size_t)nt * 64 * 128 + kt * 64, 128, 64, nullptr); } }
        else if (t < 1912) { const int q = t - 1840, nt = q / 6, kt = q % 6;
            conv_tile(C, CIN(32) + ((size_t)l * 384 + kt * 64) * 768 + nt * 64, 768, WSP(bf16_t, WS_WUQ) + (size_t)nt * 64 * 384 + kt * 64, 384, 64, CIN(30) + l * 384 + kt * 64); }
        else if (t < 1976) { const int q = t - 1912, nt = q >> 2, kt = q & 3;
            conv_tile(C, CIN(33) + ((size_t)l * 256 + kt * 64) * 1024 + nt * 64, 1024, WSP(bf16_t, WS_WUKV) + (size_t)nt * 64 * 256 + kt * 64, 256, 64, CIN(31) + l * 256 + kt * 64); }
        else if (t < 2040) { const int q = t - 1976, nt = q >> 3, kt = q & 7;
            conv_tile(C, CIN(17) + ((size_t)l * 512 + kt * 64) * 512 + nt * 64, 512, WSP(bf16_t, WS_WGLU) + (size_t)nt * 64 * 512 + kt * 64, 512, 64, nullptr); }
        else if (t < 2424) { const int q = t - 2040, j = q >> 7, r = q & 127, nt = r >> 3, kt = r & 7;
            conv_tile(C, CIN(38) + (((size_t)l * 3 + j) * 512 + kt * 64) * 1024 + nt * 64, 1024, WSP(bf16_t, WS_WBR) + ((size_t)j * 1024 + nt * 64) * 512 + kt * 64, 512, 64, nullptr); }
        else { const int q = t - 2424, nt = q >> 4, kt = q & 15;
            conv_tile(C, CIN(39) + ((size_t)l * 1024 + kt * 64) * 1024 + nt * 64, 1024, WSP(bf16_t, WS_WOUT) + (size_t)nt * 64 * 1024 + kt * 64, 1024, 64, nullptr); }
    }
}
__device__ __forceinline__ void phase_conv_moe(const Ctx& C, int l) {
    constexpr int TOTAL = 16 * 1152;
    LAS float* tile = (LAS float*)C.lds + C.wave * (64 * 65);
    const int r4 = C.lane >> 4, c4 = (C.lane & 15) * 4, nr = C.lane >> 3, ks = (C.lane & 7) * 8;
    const int t0 = C.bid * 8 + C.wave, S = C.G * 8;
    if (t0 >= TOTAL) return;
    const int n = (TOTAL - t0 + S - 1) / S;
#define CM_SRC(t_, src, sld) const float* src; int sld; { const int tq = (t_) < TOTAL ? (t_) : TOTAL - 1; const int e = tq / 1152, q = tq % 1152; \
        if (q < 768) { const int half = q / 384, r = q % 384, kt = r / 24, ct = r % 24; src = CIN(half ? 42 : 41) + ((size_t)(l * 16 + e) * 1024) * FF + (size_t)kt * 64 * FF + ct * 64; sld = FF; } \
        else { const int r = q - 768, kt = r >> 4, nt = r & 15; src = CIN(43) + ((size_t)(l * 16 + e) * FF) * 1024 + (size_t)kt * 64 * 1024 + nt * 64; sld = 1024; } }
#define CM_DST(t_, dst, dld) unsigned char* dst; int dld; { const int tq = (t_) < TOTAL ? (t_) : TOTAL - 1; const int e = tq / 1152, q = tq % 1152; \
        if (q < 768) { const int half = q / 384, r = q % 384, kt = r / 24, ct = r % 24; const int drow = (ct >> 1) * 256 + half * 128 + (ct & 1) * 64; dst = WSP(unsigned char, WS_W13) + ((size_t)e * 3072 + drow) * 1024 + kt * 64; dld = 1024; } \
        else { const int r = q - 768, kt = r >> 4, nt = r & 15; dst = WSP(unsigned char, WS_W2) + ((size_t)e * 1024 + nt * 64) * HS + kt * 64; dld = HS; } }
#define CM_LOAD(v, t_) do { CM_SRC(t_, src_, sld_); _Pragma("unroll") for (int i = 0; i < 16; ++i) v[i] = *(const f32x4*)(src_ + (size_t)(i * 4 + r4) * sld_ + c4); } while (0)
#define CM_PROC(v, t_) do { CM_DST(t_, dst_, dld_); \
        _Pragma("unroll") for (int i = 0; i < 16; ++i) { LAS float* tp = tile + (i * 4 + r4) * 65 + c4; tp[0] = v[i][0] * F8_SW; tp[1] = v[i][1] * F8_SW; tp[2] = v[i][2] * F8_SW; tp[3] = v[i][3] * F8_SW; } \
        asm volatile("s_waitcnt lgkmcnt(0)" ::: "memory"); \
        _Pragma("unroll") for (int i = 0; i < 8; ++i) { const int nn = i * 8 + nr; float o[8]; \
            _Pragma("unroll") for (int j = 0; j < 8; ++j) o[j] = tile[(ks + j) * 65 + nn]; \
            *(u32x2*)(dst_ + (size_t)nn * dld_ + ks) = (u32x2){pk4_fp8(o[0], o[1], o[2], o[3]), pk4_fp8(o[4], o[5], o[6], o[7])}; } \
        asm volatile("s_waitcnt lgkmcnt(0)" ::: "memory"); } while (0)
    f32x4 va[16], vb[16];
    CM_LOAD(va, t0);
    int k = 0;
    for (; k + 1 < n; k += 2) { const int t = t0 + k * S; CM_LOAD(vb, t + S); CM_PROC(va, t); CM_LOAD(va, t + 2 * S); CM_PROC(vb, t + S); }
    if (k < n) CM_PROC(va, t0 + k * S);
#undef CM_SRC
#undef CM_DST
#undef CM_LOAD
#undef CM_PROC
}

__device__ __forceinline__ void phase_ssm_prep(const Ctx& C) {
    LAS float* par = (LAS float*)C.lds;
    LAS float* Bb = par + 256;
    LAS float* Cc = Bb + 4096;
    LAS float* Ap = Cc + 4096;
    LAS float* Kt = Ap + 4352;
    const float* lam_re = CIN(9); const float* lam_im = CIN(10); const float* log_dt = CIN(11); const float* b_re = CIN(12); const float* b_im = CIN(13);
    const float* c_re = CIN(14); const float* c_im = CIN(15); const float* dsk = CIN(16);
    for (int un = C.G - 1 - C.bid; un < 128 && un >= 0; un += C.G) { const int l = un >> 5, g = un & 31;
        if (C.tid < 128) { const int j = C.tid >> 6, p = C.tid & 63; const float dt = __expf(log_dt[(l * 2 + j) * 32 + g]);
            const float lr = lam_re[((l * 2 + j) * 32 + g) * 64 + p], li = lam_im[((l * 2 + j) * 32 + g) * 64 + p];
            par[(j * 64 + p) * 2] = lr * dt; par[(j * 64 + p) * 2 + 1] = li * dt;
            const float mag = expf(lr * dt); float sn, cs; sincosf(li * dt, &sn, &cs); const float ar = mag * cs, ai = mag * sn, den = lr * lr + li * li, nr = ar - 1.0f, ni = ai;
            const float cr = (nr * lr + ni * li) / den, ci = (ni * lr - nr * li) / den;
            for (int ch = 0; ch < 16; ++ch) { const float br = b_re[((l * 32 + g) * 64 + p) * 16 + ch], bi = b_im[((l * 32 + g) * 64 + p) * 16 + ch];
                Bb[((j * 64 + p) * 16 + ch) * 2] = cr * br - ci * bi; Bb[((j * 64 + p) * 16 + ch) * 2 + 1] = cr * bi + ci * br; }
            if (true) { float* a16 = WSP(float, WS_A16) + (((l * 2 + j) * 32 + g) * 64 + p) * 2; const float m16 = expf(16.0f * lr * dt); float s16, c16; sincosf(16.0f * li * dt, &s16, &c16); a16[0] = m16 * c16; a16[1] = m16 * s16; }
        }
        for (int idx = C.tid; idx < 2048; idx += NTHREADS) { const int j = idx >> 10, ch = (idx >> 6) & 15, p = idx & 63;
            Cc[idx * 2] = c_re[(((l * 2 + j) * 32 + g) * 16 + ch) * 64 + p]; Cc[idx * 2 + 1] = c_im[(((l * 2 + j) * 32 + g) * 16 + ch) * 64 + p]; }
        __syncthreads();
        for (int idx = C.tid; idx < 2 * 17 * 64; idx += NTHREADS) { const int j = idx / 1088, r = idx % 1088, e = r >> 6, p = r & 63;
            const float m = expf((float)e * par[(j * 64 + p) * 2]); float sn, cs; sincosf((float)e * par[(j * 64 + p) * 2 + 1], &sn, &cs); Ap[idx * 2] = m * cs; Ap[idx * 2 + 1] = m * sn; }
        __syncthreads();
        for (int idx = C.tid; idx < 8192; idx += NTHREADS) { const int j = idx >> 12, tau = (idx >> 8) & 15, ch = (idx >> 4) & 15, cp = idx & 15; float s = 0.f;
            for (int p = 0; p < 64; ++p) { const float cr = Cc[((j * 16 + ch) * 64 + p) * 2], ci = Cc[((j * 16 + ch) * 64 + p) * 2 + 1], ar = Ap[((j * 17 + tau) * 64 + p) * 2], ai = Ap[((j * 17 + tau) * 64 + p) * 2 + 1];
                const float zr = cr * ar - ci * ai, zi = cr * ai + ci * ar; const float br = Bb[((j * 64 + p) * 16 + cp) * 2], bi = Bb[((j * 64 + p) * 16 + cp) * 2 + 1]; s += zr * br - zi * bi; }
            Kt[idx] = s; }
        __syncthreads();
        bf16_t* W1 = WSP(bf16_t, WS_W1S) + (size_t)(l * 32 + g) * 256 * 256; bf16_t* W3 = WSP(bf16_t, WS_W3S) + (size_t)(l * 32 + g) * 256 * 512;
        for (int pc = C.tid; pc < 8192; pc += NTHREADS) { const int n = pc >> 5, k0 = (pc & 31) * 8; const int j = n >> 7, p = (n >> 1) & 63, cim = n & 1, i = k0 >> 4, ch0 = k0 & 15; const int e = j == 0 ? 15 - i : i;
            const float ar = Ap[((j * 17 + e) * 64 + p) * 2], ai = Ap[((j * 17 + e) * 64 + p) * 2 + 1]; float o[8];
#pragma unroll
            for (int q = 0; q < 8; ++q) { const float br = Bb[((j * 64 + p) * 16 + ch0 + q) * 2], bi = Bb[((j * 64 + p) * 16 + ch0 + q) * 2 + 1]; o[q] = cim ? ar * bi + ai * br : ar * br - ai * bi; }
            *(u32x4*)(W1 + (size_t)n * 256 + k0) = pack8(o); }
        for (int pc = C.tid; pc < 16384; pc += NTHREADS) { const int n = pc >> 6, k0 = (pc & 63) * 8; const int i = n >> 4, ch = n & 15; float o[8];
            if (k0 < 256) { const int ip = k0 >> 4, cp0 = k0 & 15;
#pragma unroll
                for (int q = 0; q < 8; ++q) { float s = 0.f; if (ip <= i) s += Kt[((0 * 16 + (i - ip)) * 16 + ch) * 16 + cp0 + q]; if (ip >= i) s += Kt[((1 * 16 + (ip - i)) * 16 + ch) * 16 + cp0 + q];
                    if (ip == i && cp0 + q == ch) s += dsk[l * 512 + g * 16 + ch]; o[q] = s; } }
            else { const int kk = k0 - 256, j = kk >> 7, p0 = (kk & 127) >> 1; const int e = j == 0 ? i + 1 : 16 - i;
#pragma unroll
                for (int q = 0; q < 4; ++q) { const int p = p0 + q; const float cr = Cc[((j * 16 + ch) * 64 + p) * 2], ci = Cc[((j * 16 + ch) * 64 + p) * 2 + 1], ar = Ap[((j * 17 + e) * 64 + p) * 2], ai = Ap[((j * 17 + e) * 64 + p) * 2 + 1];
                    o[2 * q] = cr * ar - ci * ai; o[2 * q + 1] = -(cr * ai + ci * ar); } }
            *(u32x4*)(W3 + (size_t)n * 512 + k0) = pack8(o); }
        __syncthreads();
    }
}

__device__ __forceinline__ void phase_ssm_step2(const Ctx& C, int l) {
    const int gt = C.bid * NTHREADS + C.tid; if (gt >= 32 * 16 * 2 * 64) return;
    const int p = gt & 63, j = (gt >> 6) & 1, b = (gt >> 7) & 15, g = gt >> 11;
    const float* a16 = WSP(float, WS_A16) + (((l * 2 + j) * 32 + g) * 64 + p) * 2; const float ar = a16[0], ai = a16[1];
    const float* E = WSP(float, WS_E) + (size_t)g * NCHROW * 256 + j * 128 + p * 2; bf16_t* X = WSP(bf16_t, WS_UT) + (size_t)g * NCHROW * 512 + 256 + j * 128 + p * 2;
    float xr = 0.f, xi = 0.f;
#define S2_ROW(s_) ((s_) < 16 ? 2048 + b * 16 + (j == 0 ? (s_) : 15 - (s_)) : b * 128 + (j == 0 ? (s_) - 16 : 127 - ((s_) - 16)))
#define S2_LOAD(ev, s0_) do { _Pragma("unroll") for (int q = 0; q < 8; ++q) { const int s = (s0_) + q < 144 ? (s0_) + q : 143; ev[q] = *(const f32x2*)(E + (size_t)S2_ROW(s) * 256); } } while (0)
#define S2_FOLD(ev, s0_) do { _Pragma("unroll") for (int q = 0; q < 8; ++q) { const int s = (s0_) + q; *(unsigned*)(X + (size_t)S2_ROW(s) * 512) = pk2(xr, xi); const float nr = ar * xr - ai * xi + ev[q].x, ni = ar * xi + ai * xr + ev[q].y; xr = nr; xi = ni; } } while (0)
    f32x2 ea[8], eb[8];
    S2_LOAD(ea, 0);
    for (int s0 = 0; s0 < 144; s0 += 16) { S2_LOAD(eb, s0 + 8); S2_FOLD(ea, s0); S2_LOAD(ea, s0 + 16); S2_FOLD(eb, s0 + 8); }
#undef S2_ROW
#undef S2_LOAD
#undef S2_FOLD
}

__device__ __forceinline__ void moe_combine(const Ctx& C, int mys, f32x4 (&acc)[4]) {
    const bf16_t* Y = WSP(bf16_t, WS_YBUF);
#pragma unroll
    for (int i = 0; i < 4; ++i) acc[i] = (f32x4){0.f, 0.f, 0.f, 0.f};
    unsigned mask = (unsigned)__ballot(C.lane < 16 && mys >= 0);
    while (mask) {
        u32x2 w[4][4]; int cnt = 0;
#pragma unroll
        for (int q = 0; q < 4; ++q) if (mask) { const int e = __builtin_ctz(mask); mask &= mask - 1; const int s = __builtin_amdgcn_readlane(mys, e); ++cnt;
            const bf16_t* yr = Y + ((size_t)e * EROWS + s) * 1024 + 4 * C.lane;
#pragma unroll
            for (int i = 0; i < 4; ++i) w[q][i] = *(const u32x2*)(yr + 256 * i); }
#pragma unroll
        for (int q = 0; q < 4; ++q) if (q < cnt) {
#pragma unroll
            for (int i = 0; i < 4; ++i) { acc[i][0] += bflo(w[q][i].x); acc[i][1] += bfhi(w[q][i].x); acc[i][2] += bflo(w[q][i].y); acc[i][3] += bfhi(w[q][i].y); } }
    }
}
__device__ __forceinline__ void phase_norm1(const Ctx& C, int l) {
    const float* MODl = WSP(float, WS_MOD) + (size_t)l * 17 * 6144; const float* MODp = WSP(float, WS_MOD) + (size_t)(l - 1) * 17 * 6144;
    const float* g1 = CIN(6) + l * 1024; bf16_t* H = WSP(bf16_t, WS_H); unsigned char* H8 = WSP(unsigned char, WS_H8); bf16_t* XB = WSP(bf16_t, WS_XB);
    const int stride = C.G * 8; const bool first = (l == 0); const float* xl_src = CIN(0); const float* xc_src = CIN(2); const int* SL = WSP(int, WS_SLOT);
    f32x4 xnext[4]; u32x2 xnb[4]; int snext = -1;
#pragma unroll
    for (int i = 0; i < 4; ++i) { xnext[i] = (f32x4){0.f, 0.f, 0.f, 0.f}; xnb[i] = (u32x2){0u, 0u}; }
#define N1_LOAD(rw) do { if (first) { const float* p0 = (rw) < NL ? xl_src + (size_t)(rw) * 1024 : xc_src + (size_t)((rw) - NL) * 1024; \
            _Pragma("unroll") for (int i = 0; i < 4; ++i) xnext[i] = *(const f32x4*)(p0 + 4 * C.lane + 256 * i); } \
        else { _Pragma("unroll") for (int i = 0; i < 4; ++i) xnb[i] = *(const u32x2*)(XB + (size_t)(rw) * 1024 + 4 * C.lane + 256 * i); \
            if (C.lane < 16) snext = SL[(size_t)(rw) * 16 + C.lane]; } } while (0)
    { const int r0 = C.bid * 8 + C.wave; if (r0 < NT) N1_LOAD(r0); }
    for (int row = C.bid * 8 + C.wave; row < NT; row += stride) {
        const bool lat = row < NL; const int mrow = lat ? (row >> 11) : 16;
        bf16_t* xout = XB + (size_t)row * 1024;
        f32x4 x[4]; const int mys = snext;
#pragma unroll
        for (int i = 0; i < 4; ++i) x[i] = first ? xnext[i] : (f32x4){bflo(xnb[i].x), bfhi(xnb[i].x), bflo(xnb[i].y), bfhi(xnb[i].y)};
        { const int rn = row + stride; if (rn < NT) N1_LOAD(rn); }
        if (!first) { f32x4 a[4]; moe_combine(C, mys, a);
#pragma unroll
            for (int i = 0; i < 4; ++i) { const f32x4 g5 = *(const f32x4*)(MODp + (size_t)mrow * 6144 + 5 * 1024 + 4 * C.lane + 256 * i); x[i] += g5 * a[i]; } }
#pragma unroll
        for (int i = 0; i < 4; ++i) { u32x2 w; w.x = pk2(x[i][0], x[i][1]); w.y = pk2(x[i][2], x[i][3]); *(u32x2*)(xout + 4 * C.lane + 256 * i) = w; }
        float ss = 0.f;
#pragma unroll
        for (int i = 0; i < 4; ++i) ss += x[i][0] * x[i][0] + x[i][1] * x[i][1] + x[i][2] * x[i][2] + x[i][3] * x[i][3];
        ss = red64(ss); const float rstd = rsqrtf(ss * (1.0f / 1024.0f) + NORM_EPS);
#pragma unroll
        for (int i = 0; i < 4; ++i) { const int col = 4 * C.lane + 256 * i; const f32x4 gg = *(const f32x4*)(g1 + col), sh = *(const f32x4*)(MODl + (size_t)mrow * 6144 + col), sc = *(const f32x4*)(MODl + (size_t)mrow * 6144 + 1024 + col);
            const f32x4 h = (x[i] * rstd * gg) * (sc + 1.0f) + sh; u32x2 w; w.x = pk2(h[0], h[1]); w.y = pk2(h[2], h[3]); *(u32x2*)(H + (size_t)row * 1024 + col) = w;
            const f32x4 h8 = h * F8_SX; *(unsigned*)(H8 + (size_t)row * 1024 + col) = pk4_fp8(h8[0], h8[1], h8[2], h8[3]); }
    }
#undef N1_LOAD
}
__device__ __forceinline__ void phase_final(const Ctx& C) {
    const float* MODp = WSP(float, WS_MOD) + (size_t)(DEPTH - 1) * 17 * 6144; const bf16_t* XB = WSP(bf16_t, WS_XB); const int* SL = WSP(int, WS_SLOT);
    const int stride = C.G * 8; u32x2 xn[4]; int snext = -1;
#pragma unroll
    for (int i = 0; i < 4; ++i) xn[i] = (u32x2){0u, 0u};
    { const int r0 = C.bid * 8 + C.wave; if (r0 < NL) {
#pragma unroll
        for (int i = 0; i < 4; ++i) xn[i] = *(const u32x2*)(XB + (size_t)r0 * 1024 + 4 * C.lane + 256 * i);
        if (C.lane < 16) snext = SL[(size_t)r0 * 16 + C.lane]; } }
    for (int row = C.bid * 8 + C.wave; row < NL; row += stride) {
        u32x2 xb[4]; const int mys = snext;
#pragma unroll
        for (int i = 0; i < 4; ++i) xb[i] = xn[i];
        { const int rn = row + stride; if (rn < NL) {
#pragma unroll
            for (int i = 0; i < 4; ++i) xn[i] = *(const u32x2*)(XB + (size_t)rn * 1024 + 4 * C.lane + 256 * i);
            if (C.lane < 16) snext = SL[(size_t)rn * 16 + C.lane]; } }
        f32x4 a[4]; moe_combine(C, mys, a); float* xr = C.out + (size_t)row * 1024;
#pragma unroll
        for (int i = 0; i < 4; ++i) { const int col = 4 * C.lane + 256 * i; const f32x4 g5 = *(const f32x4*)(MODp + (size_t)(row >> 11) * 6144 + 5 * 1024 + col);
            *(f32x4*)(xr + col) = (f32x4){bflo(xb[i].x), bfhi(xb[i].x), bflo(xb[i].y), bfhi(xb[i].y)} + g5 * a[i]; }
    }
}
__device__ __forceinline__ void phase_router_prep(const Ctx& C, int l) {
    const float* MODl = WSP(float, WS_MOD) + (size_t)l * 17 * 6144; const float* g2 = CIN(7) + l * 1024; const float* rw = CIN(40) + (size_t)l * 1024 * 16;
    unsigned short* GRW = WSP(unsigned short, WS_GRW); float* GV = WSP(float, WS_GV); float* BIAS = WSP(float, WS_RBIAS);
    for (int idx = C.bid * NTHREADS + C.tid; idx < 17 * 16 * 1024; idx += C.G * NTHREADS) { const int k = idx & 1023, e = (idx >> 10) & 15, b = idx >> 14;
        const float gvv = g2[k] * (MODl[(size_t)b * 6144 + 4 * 1024 + k] + 1.0f); const float v = gvv * rw[k * 16 + e];
        const unsigned hi = pk2(v, 0.f) & 0xffffu; const float r1 = v - bflo(hi); const unsigned mid = pk2(r1, 0.f) & 0xffffu; const float r2 = r1 - bflo(mid); const unsigned lo = pk2(r2, 0.f) & 0xffffu;
        unsigned short* gp = GRW + ((size_t)(b * 3) * 16 + e) * 1024 + k; gp[0] = (unsigned short)hi; gp[16 * 1024] = (unsigned short)mid; gp[2 * 16 * 1024] = (unsigned short)lo;
        if (e == 0) GV[b * 1024 + k] = gvv; }
    if (C.bid < 17) { const int b = C.bid;
#pragma unroll
        for (int q = 0; q < 2; ++q) { const int e = C.wave * 2 + q; float s = 0.f;
            for (int i = 0; i < 16; ++i) { const int k = C.lane + 64 * i; s += MODl[(size_t)b * 6144 + 3 * 1024 + k] * rw[k * 16 + e]; }
            s = red64(s); if (C.lane == 0) BIAS[b * 16 + e] = s; } }
}
__device__ __forceinline__ void phase_norm2(const Ctx& C, int l, int nrows) {
    LAS float* part = (LAS float*)C.lds;
    LAS float* ssp = part + 2 * 8 * 64 * 4;
    const float* MODl = WSP(float, WS_MOD) + (size_t)l * 17 * 6144; bf16_t* H = WSP(bf16_t, WS_H); const bf16_t* XB = WSP(bf16_t, WS_XB); float* AFF = WSP(float, WS_AFF);
    const bf16_t* GRW = WSP(bf16_t, WS_GRW); const float* GV = WSP(float, WS_GV); const float* BIAS = WSP(float, WS_RBIAS);
    const int r = C.lane & 15, kq = C.lane >> 4, kw = C.wave * 128 + 8 * kq, nblk = nrows >> 4;
    u32x4 xa[4], xn[4];
#pragma unroll
    for (int c = 0; c < 4; ++c) xn[c] = (u32x4){0u, 0u, 0u, 0u};
    if (C.bid < nblk) {
#pragma unroll
        for (int c = 0; c < 4; ++c) xn[c] = *(const u32x4*)(XB + (size_t)(C.bid * 16 + r) * 1024 + kw + 32 * c); }
    int it = 0;
    for (int blk = C.bid; blk < nblk; blk += C.G, ++it) {
        const int row0 = blk * 16, b = row0 < NL ? (row0 >> 11) : 16, buf = it & 1;
#pragma unroll
        for (int c = 0; c < 4; ++c) xa[c] = xn[c];
        if (blk + C.G < nblk) {
#pragma unroll
            for (int c = 0; c < 4; ++c) xn[c] = *(const u32x4*)(XB + (size_t)((blk + C.G) * 16 + r) * 1024 + kw + 32 * c); }
        f32x4 acc = (f32x4){0.f, 0.f, 0.f, 0.f}; float ss = 0.f;
#pragma unroll
        for (int c = 0; c < 4; ++c) { const bf16x8 xo = __builtin_bit_cast(bf16x8, xa[c]);
#pragma unroll
            for (int s = 0; s < 3; ++s) { const bf16x8 go = *(const bf16x8*)(GRW + ((size_t)(b * 3 + s) * 16 + r) * 1024 + kw + 32 * c); acc = __builtin_amdgcn_mfma_f32_16x16x32_bf16(go, xo, acc, 0, 0, 0); }
            float f[8]; unpack8(xa[c], f);
#pragma unroll
            for (int j = 0; j < 8; ++j) ss += f[j] * f[j]; }
        ss += __shfl_xor(ss, 16); ss += __shfl_xor(ss, 32);
        *(LAS f32x4*)(part + ((buf * 8 + C.wave) * 64 + C.lane) * 4) = acc; if (C.lane < 16) ssp[(buf * 8 + C.wave) * 16 + C.lane] = ss;
        __syncthreads();
        float tot = 0.f;
#pragma unroll
        for (int w = 0; w < 8; ++w) tot += ssp[(buf * 8 + w) * 16 + r];
        const float rstd = rsqrtf(tot * (1.0f / 1024.0f) + NORM_EPS);
#pragma unroll
        for (int c = 0; c < 4; ++c) { const int k0 = kw + 32 * c; const f32x4 g0 = *(const f32x4*)(GV + b * 1024 + k0), g1 = *(const f32x4*)(GV + b * 1024 + k0 + 4);
            const f32x4 s0 = *(const f32x4*)(MODl + (size_t)b * 6144 + 3 * 1024 + k0), s1 = *(const f32x4*)(MODl + (size_t)b * 6144 + 3 * 1024 + k0 + 4);
            float f[8], h[8]; unpack8(xa[c], f);
#pragma unroll
            for (int j = 0; j < 4; ++j) { h[j] = (f[j] * rstd) * g0[j] + s0[j]; h[4 + j] = (f[4 + j] * rstd) * g1[j] + s1[j]; }
            *(u32x2*)((unsigned char*)H + (size_t)(row0 + r) * 1024 + k0) = (u32x2){pk4_fp8(h[0] * F8_SX, h[1] * F8_SX, h[2] * F8_SX, h[3] * F8_SX), pk4_fp8(h[4] * F8_SX, h[5] * F8_SX, h[6] * F8_SX, h[7] * F8_SX)}; }
        if (C.lane < 32) { const int rl = 2 * C.wave + (C.lane >> 4), e = C.lane & 15; float t2 = 0.f, lg = 0.f;
#pragma unroll
            for (int w = 0; w < 8; ++w) { t2 += ssp[(buf * 8 + w) * 16 + rl]; lg += part[((buf * 8 + w) * 64 + rl + 16 * (e >> 2)) * 4 + (e & 3)]; }
            lg = rsqrtf(t2 * (1.0f / 1024.0f) + NORM_EPS) * lg + BIAS[b * 16 + e];
            const float mx = max16(lg); const float ex = __expf(lg - mx); const float sum = red16(ex);
            AFF[(size_t)(row0 + rl) * 16 + e] = ex / sum; }
    }
    __syncthreads();
}

__device__ __forceinline__ void phase_topk(const Ctx& C, int nunits) {
    LAS unsigned* hist = (LAS unsigned*)C.lds;
    LAS unsigned* ctl = hist + 256;
    LAS unsigned* wsum = hist + 272;
    LAS int* lrow = (LAS int*)(hist + 288);
    const bf16_t* H = WSP(bf16_t, WS_H); unsigned char* XS = WSP(unsigned char, WS_XS);
    const float* AFF = WSP(float, WS_AFF); int* SLOT = WSP(int, WS_SLOT); int* IDX = WSP(int, WS_IDX); float* GATE = WSP(float, WS_GATE);
    for (int u = C.bid; u < nunits; u += C.G) {
        const bool lat = u < 256; const int b = (u & 255) >> 4, e = u & 15; const int n = lat ? 2048 : 256; const unsigned cap = lat ? 256u : 32u; const int row0 = lat ? b * 2048 : NL + b * 256; const int pos0 = lat ? b * 256 : 4096 + b * 32;
        unsigned key[4];
#pragma unroll
        for (int q = 0; q < 4; ++q) { const int idx = q * NTHREADS + C.tid; key[q] = idx < n ? __float_as_uint(AFF[(size_t)(row0 + idx) * 16 + e]) + 1u : 0u; }
        if (C.tid == 0) { ctl[0] = 0u; ctl[1] = cap; }
        unsigned prefix = 0u;
#pragma unroll 1
        for (int pass = 0; pass < 4; ++pass) {
            const int shift = 24 - 8 * pass; const unsigned himask = pass == 0 ? 0u : (0xffffffffu << (shift + 8));
            if (C.tid < 256) hist[C.tid] = 0u;
            __syncthreads();
#pragma unroll
            for (int q = 0; q < 4; ++q) if (key[q] != 0u && (key[q] & himask) == prefix) __hip_atomic_fetch_add(&hist[(key[q] >> shift) & 255u], 1u, __ATOMIC_RELAXED, __HIP_MEMORY_SCOPE_WORKGROUP);
            __syncthreads();
            if (C.wave == 0) {
                const unsigned remaining = ctl[1];
                const unsigned h0 = hist[4 * C.lane], h1 = hist[4 * C.lane + 1], h2 = hist[4 * C.lane + 2], h3 = hist[4 * C.lane + 3];
                unsigned s = h0 + h1 + h2 + h3;
#pragma unroll
                for (int d = 1; d < 64; d <<= 1) { const unsigned t = __shfl_down(s, d); if (C.lane + d < 64) s += t; }
                const unsigned above = s - (h0 + h1 + h2 + h3);
                const bool mine = s >= remaining && above < remaining;
                if (mine) { unsigned acc = above, bsel, cnt;
                    if (acc + h3 >= remaining) { bsel = 3u; cnt = h3; } else { acc += h3; if (acc + h2 >= remaining) { bsel = 2u; cnt = h2; } else { acc += h2; if (acc + h1 >= remaining) { bsel = 1u; cnt = h1; } else { acc += h1; bsel = 0u; cnt = h0; } } }
                    ctl[0] = prefix | ((4u * C.lane + bsel) << shift); ctl[1] = remaining - acc; ctl[2] = cnt; }
            }
            __syncthreads();
            prefix = ctl[0];
        }
        const unsigned thr = prefix, need_eq = ctl[1], cnt_eq = ctl[2];
        bool sel[4];
#pragma unroll
        for (int q = 0; q < 4; ++q) sel[q] = key[q] != 0u && key[q] >= thr;
        if (cnt_eq > need_eq) {
            unsigned base = 0u;
#pragma unroll 1
            for (int q = 0; q < 4; ++q) {
                const bool eq = key[q] == thr && thr != 0u; const unsigned long long bal = __ballot(eq); const unsigned lanepre = __builtin_popcountll(bal & ((1ull << C.lane) - 1ull));
                __syncthreads(); if (C.lane == 0) wsum[C.wave] = (unsigned)__builtin_popcountll(bal); __syncthreads();
                unsigned wpre = 0u, tot = 0u;
#pragma unroll
                for (int w = 0; w < 8; ++w) { const unsigned x = wsum[w]; if (w < C.wave) wpre += x; tot += x; }
                if (eq && base + wpre + lanepre >= need_eq) sel[q] = false;
                base += tot;
            }
        }
        const unsigned mycnt = (unsigned)sel[0] + (unsigned)sel[1] + (unsigned)sel[2] + (unsigned)sel[3];
        unsigned incl = mycnt;
#pragma unroll
        for (int d = 1; d < 64; d <<= 1) { const unsigned t = __shfl_up(incl, d); if (C.lane >= d) incl += t; }
        __syncthreads(); if (C.lane == 63) wsum[C.wave] = incl; __syncthreads();
        unsigned wpre = 0u;
#pragma unroll
        for (int w = 0; w < 8; ++w) if (w < C.wave) wpre += wsum[w];
        unsigned slot = wpre + incl - mycnt;
#pragma unroll
        for (int q = 0; q < 4; ++q) { const int idx = q * NTHREADS + C.tid; if (idx < n) { const int row = row0 + idx;
            if (sel[q]) { const int pos = pos0 + (int)slot; lrow[slot] = row; ++slot; SLOT[(size_t)row * 16 + e] = pos; IDX[e * EROWS + pos] = row; GATE[e * EROWS + pos] = __uint_as_float(key[q] - 1u); }
            else SLOT[(size_t)row * 16 + e] = -1; } }
        __syncthreads();
        for (int j0 = 0; j0 < (int)cap / 8; j0 += 8) { u32x4 v[8];
#pragma unroll
            for (int jj = 0; jj < 8; ++jj) { const int s = C.wave + 8 * (j0 + jj); const int srow = lrow[s < (int)cap ? s : 0]; v[jj] = *(const u32x4*)((const unsigned char*)H + (size_t)srow * 1024 + 16 * C.lane); }
#pragma unroll
            for (int jj = 0; jj < 8; ++jj) { const int s = C.wave + 8 * (j0 + jj); if (s < (int)cap) *(u32x4*)(XS + ((size_t)e * EROWS + pos0 + s) * 1024 + 16 * C.lane) = v[jj]; } }
        __syncthreads();
    }
}
__device__ __forceinline__ void phase_gather(const Ctx& C, int erows) {
    const int* IDX = WSP(int, WS_IDX); const bf16_t* H = WSP(bf16_t, WS_H); bf16_t* XS = WSP(bf16_t, WS_XS);
    for (int r = C.bid * 8 + C.wave; r < 16 * EROWS; r += C.G * 8) { if (r % EROWS >= erows) continue; const int src = __builtin_amdgcn_readfirstlane(IDX[r]);
        const u32x4* s = (const u32x4*)(H + (size_t)src * 1024); u32x4* d = (u32x4*)(XS + (size_t)r * 1024); d[C.lane] = s[C.lane]; d[C.lane + 64] = s[C.lane + 64]; }
}

__device__ __forceinline__ void phase_rwkv_pre(const Ctx& C, int l) {
    const bf16_t* P = WSP(bf16_t, WS_P); bf16_t* RK = WSP(bf16_t, WS_RKVK); bf16_t* LIN = WSP(bf16_t, WS_LIN);
    const float* mu = CIN(19) + l * 1920; const float* k_k = CIN(25) + l * 512;
    float muv[4][8], kkg[8];
#pragma unroll
    for (int r = 0; r < 4; ++r)
#pragma unroll
        for (int j = 0; j < 8; ++j) { const int col = (r * 64 + C.lane) * 8 + j; muv[r][j] = col < 1920 ? mu[col] : 0.f; }
#pragma unroll
    for (int j = 0; j < 8; ++j) kkg[j] = k_k[C.lane * 8 + j];
    const bool act3 = C.lane < 48;
    for (int run = C.bid * 8 + C.wave; run < NT / 16; run += C.G * 8) {
        const int row0 = run * 16; const bool lat = row0 < NL; const int tpos0 = lat ? (row0 & 2047) : ((row0 - NL) & 255); const int tlen = lat ? 2048 : 256;
        u32x4 pv[4], cu[4], nx[4];
        const u32x4 zero4 = (u32x4){0u, 0u, 0u, 0u};
#pragma unroll
        for (int r = 0; r < 4; ++r) { const bool ok = r < 3 || act3; const size_t off = (size_t)(r * 64 + C.lane) * 8;
            pv[r] = (ok && tpos0 > 0) ? *(const u32x4*)(P + (size_t)(row0 - 1) * LDP + off) : zero4;
            cu[r] = ok ? *(const u32x4*)(P + (size_t)row0 * LDP + off) : zero4; }
        for (int i = 0; i < 16; ++i) {
            const int row = row0 + i; const bool hasn = (tpos0 + i + 1) < tlen;
#pragma unroll
            for (int r = 0; r < 4; ++r) { const bool ok = r < 3 || act3; nx[r] = (ok && hasn) ? *(const u32x4*)(P + (size_t)(row + 1) * LDP + (size_t)(r * 64 + C.lane) * 8) : zero4; }
#pragma unroll
            for (int r = 0; r < 4; ++r) {
                float a[8], b[8], c[8], m[8]; unpack8(pv[r], a); unpack8(cu[r], c); unpack8(nx[r], b);
#pragma unroll
                for (int j = 0; j < 8; ++j) m[j] = c[j] + muv[r][j] * (0.5f * (a[j] + b[j]) - c[j]);
                if (r == 0) *(u32x4*)(RK + (size_t)row * 2048 + C.lane * 8) = pack8(m);
                if (r == 1) { *(u32x4*)(RK + (size_t)row * 2048 + 512 + C.lane * 8) = pack8(m); float ss = 0.f;
#pragma unroll
                    for (int j = 0; j < 8; ++j) { m[j] *= kkg[j]; ss += m[j] * m[j]; }
                    ss = red8(ss); const float rn = rsqrtf(ss + 1e-12f);
#pragma unroll
                    for (int j = 0; j < 8; ++j) m[j] *= rn;
                    *(u32x4*)(RK + (size_t)row * 2048 + 1536 + C.lane * 8) = pack8(m); }
                if (r == 2) *(u32x4*)(RK + (size_t)row * 2048 + 1024 + C.lane * 8) = pack8(m);
                if (r == 3 && act3) {
#pragma unroll
                    for (int j = 0; j < 8; ++j) { if (C.lane < 16) m[j] = 1.0f - 2.0f * __builtin_amdgcn_rcpf(__expf(2.0f * m[j]) + 1.0f); else if (C.lane >= 32) m[j] = sigmoidf_(m[j]); }
                    const int lc = C.lane < 8 ? C.lane * 8 : (C.lane < 16 ? 128 + (C.lane - 8) * 8 : (C.lane < 24 ? 64 + (C.lane - 16) * 8 : (C.lane < 32 ? 192 + (C.lane - 24) * 8 : C.lane * 8)));
                    *(u32x4*)(LIN + (size_t)row * 384 + lc) = pack8(m); }
            }
#pragma unroll
            for (int r = 0; r < 4; ++r) { pv[r] = cu[r]; cu[r] = nx[r]; }
        }
    }
}

typedef short s16x4 __attribute__((ext_vector_type(4)));
typedef __bf16 bf2_t __attribute__((ext_vector_type(2)));
__device__ __forceinline__ unsigned pkb(float lo, float hi) { const bf2_t v = __builtin_convertvector((f32x2){lo, hi}, bf2_t); return __builtin_bit_cast(unsigned, v); }
__device__ __forceinline__ s16x4 pack4(const f32x4& c) { return __builtin_bit_cast(s16x4, (u32x2){pkb(c[0], c[1]), pkb(c[2], c[3])}); }
#define MF32(a, b, c) __builtin_amdgcn_mfma_f32_16x16x32_bf16((a), (b), (c), 0, 0, 0)
#define MF16(a, b, c) __builtin_amdgcn_mfma_f32_16x16x16bf16_1k((a), (b), (c), 0, 0, 0)
#define RW_BAR() do { asm volatile("s_waitcnt lgkmcnt(0)" ::: "memory"); __builtin_amdgcn_s_barrier(); asm volatile("" ::: "memory"); } while (0)
constexpr int RW_RAW = 4 * 12288;
constexpr int RW_SLOT = 18432;
__device__ __forceinline__ int rw_token(int b, int dir, int pos) { return (pos < 256) ? (NL + b * 256 + (dir ? 255 - pos : pos)) : (b * 2048 + (dir ? 2047 - (pos - 256) : pos - 256)); }
__device__ __forceinline__ void phase_rwkv_scan(const Ctx& C, int l) {
    const bf16_t* RK = WSP(bf16_t, WS_RKVK); const bf16_t* LO = WSP(bf16_t, WS_LOUT); bf16_t* Y2 = WSP(bf16_t, WS_Y2);
    const int fr = C.lane & 15, g = C.lane >> 4;
    const f32x4 zero4 = (f32x4){0.f, 0.f, 0.f, 0.f};
    for (int item = C.bid; item < 256; item += C.G) {
        const int b = item >> 4, h = (item >> 1) & 7, dir = item & 1;
        if (C.wave < 4) {
            const int w = C.wave;
            f32x4 Hs[4] = {zero4, zero4, zero4, zero4};
            f32x4 Ic; bool mlt[4], mle[4], mgt[4];
#pragma unroll
            for (int j = 0; j < 4; ++j) { const int ri = 4 * g + j; Ic[j] = ri == fr ? 1.f : 0.f; mlt[j] = ri < fr; mle[j] = ri <= fr; mgt[j] = ri > fr; }
            RW_BAR();
#pragma unroll 1
            for (int i = -4; i < 144; ++i) {
                if (i >= 0) {
                    const LAS unsigned char* S = C.lds + RW_RAW + (i % 5) * RW_SLOT;
                    bf16x8 fKK[2], fR[2], fKD[2], fB[2];
#pragma unroll
                    for (int ks = 0; ks < 2; ++ks) { const int o = (fr * 68 + 32 * ks + 4 * g) * 2;
                        { const u32x2 lo = *(const LAS u32x2*)(S + o), hi = *(const LAS u32x2*)(S + o + 32); fKK[ks] = __builtin_bit_cast(bf16x8, (u32x4){lo.x, lo.y, hi.x, hi.y}); }
                        { const u32x2 lo = *(const LAS u32x2*)(S + 2176 + o), hi = *(const LAS u32x2*)(S + 2176 + o + 32); fR[ks] = __builtin_bit_cast(bf16x8, (u32x4){lo.x, lo.y, hi.x, hi.y}); }
                        { const u32x2 lo = *(const LAS u32x2*)(S + 4352 + o), hi = *(const LAS u32x2*)(S + 4352 + o + 32); fKD[ks] = __builtin_bit_cast(bf16x8, (u32x4){lo.x, lo.y, hi.x, hi.y}); }
                        { const u32x2 lo = *(const LAS u32x2*)(S + 6528 + o), hi = *(const LAS u32x2*)(S + 6528 + o + 32); fB[ks] = __builtin_bit_cast(bf16x8, (u32x4){lo.x, lo.y, hi.x, hi.y}); } }
                    const s16x4 fV = *(const LAS s16x4*)(S + 8704 + ((16 * w + fr) * 24 + 4 * g) * 2);
                    bf16x8 bH[2];
#pragma unroll
                    for (int ks = 0; ks < 2; ++ks) bH[ks] = __builtin_bit_cast(bf16x8, (u32x4){pkb(Hs[2 * ks][0], Hs[2 * ks][1]), pkb(Hs[2 * ks][2], Hs[2 * ks][3]), pkb(Hs[2 * ks + 1][0], Hs[2 * ks + 1][1]), pkb(Hs[2 * ks + 1][2], Hs[2 * ks + 1][3])});
                    f32x4 M1 = zero4, M2 = zero4, M2p = zero4, M3 = zero4, M4 = zero4, KH = zero4, RH = zero4;
#pragma unroll
                    for (int ks = 0; ks < 2; ++ks) { M2p = MF32(fKK[ks], fB[ks], M2p); M2 = MF32(fB[ks], fKK[ks], M2); M1 = MF32(fKD[ks], fKK[ks], M1); KH = MF32(fKK[ks], bH[ks], KH);
                        M3 = MF32(fKD[ks], fR[ks], M3); M4 = MF32(fB[ks], fR[ks], M4); RH = MF32(fR[ks], bH[ks], RH); }
                    f32x4 Nc, Ntc;
#pragma unroll
                    for (int j = 0; j < 4; ++j) { Nc[j] = mgt[j] ? M2p[j] : 0.f; Ntc[j] = mlt[j] ? M2[j] : 0.f; M1[j] = mlt[j] ? M1[j] : 0.f; M3[j] = mle[j] ? M3[j] : 0.f; M4[j] = mle[j] ? M4[j] : 0.f; }
                    const s16x4 pN = pack4(Nc), pNt = pack4(Ntc);
                    const f32x4 N2c = MF16(pNt, pN, zero4), N2tc = MF16(pN, pNt, zero4);
                    const f32x4 RHS = MF16(pack4(M1), fV, KH);
                    const s16x4 pN2 = pack4(N2c), pN2t = pack4(N2tc);
                    const f32x4 N4c = MF16(pN2t, pN2, zero4), N4tc = MF16(pN2, pN2t, zero4);
                    const f32x4 Z1c = MF16(pack4(Ic - Nc), pack4(Ic + N2tc), zero4);
                    const s16x4 pN4 = pack4(N4c), pN4t = pack4(N4tc);
                    const f32x4 N8tc = MF16(pN4, pN4t, zero4);
                    const f32x4 Z2tc = MF16(pack4(Z1c), pack4(Ic + N4c), zero4);
                    const f32x4 Z3c = MF16(pack4(Z2tc), pack4(Ic + N8tc), zero4);
                    const f32x4 Uc = MF16(pack4(Z3c), pack4(RHS), zero4);
                    const s16x4 nU = pack4(-Uc);
                    f32x4 Y = MF16(pack4(M3), fV, RH); Y = MF16(pack4(M4), nU, Y);
#pragma unroll
                    for (int mt = 0; mt < 4; ++mt) { const f32x4 p15 = *(const LAS f32x4*)(S + 17920 + (16 * mt + 4 * g) * 4);
                        const s16x4 aKD = *(const LAS s16x4*)(S + 11776 + ((16 * mt + fr) * 24 + 4 * g) * 2), aB = *(const LAS s16x4*)(S + 14848 + ((16 * mt + fr) * 24 + 4 * g) * 2);
                        f32x4 hh = Hs[mt] * p15; hh = MF16(aKD, fV, hh); Hs[mt] = MF16(aB, nU, hh); }
#pragma unroll
                    for (int j = 0; j < 4; ++j) { const int tok = rw_token(b, dir, 16 * i + 4 * g + j); Y2[((size_t)dir * NT + tok) * 512 + h * 64 + 16 * w + fr] = (bf16_t)(pkb(Y[j], 0.f) & 0xffffu); }
                }
                RW_BAR();
            }
        } else {
            const int pi = C.wave - 4; const float ka = CIN(26)[l * 512 + h * 64 + C.lane];
            LAS unsigned char* raw = C.lds + pi * 12288;
            const int rr = C.lane >> 3, seg = C.lane & 7;
            const int sgn = dir ? -1 : 1; int loff[3];
#pragma unroll
            for (int j3 = 0; j3 < 3; ++j3) { const int arr_ = 2 * j3 + (rr >> 2); loff[j3] = (arr_ < 4 ? sgn * (rr & 3) * 2048 + arr_ * 512 : sgn * (rr & 3) * 2560 + (arr_ - 4) * 1024 + dir * 512) + h * 64 + seg * 8; }
#define RW_ISSUE_Q(c, q) do { const int p0_ = 16 * (c); const int T0_ = (p0_ < 256 ? NL + b * 256 + (dir ? 255 - p0_ : p0_) : b * 2048 + (dir ? 2047 - (p0_ - 256) : p0_ - 256)) + sgn * 4 * (q); \
            _Pragma("unroll") for (int j3 = 0; j3 < 3; ++j3) { const bf16_t* sb_ = j3 < 2 ? RK + (size_t)T0_ * 2048 : LO + (size_t)T0_ * 2560;     \
                __builtin_amdgcn_global_load_lds((const unsigned*)(sb_ + loff[j3]), (LAS unsigned*)(raw + ((q) * 3 + j3) * 1024), 16, 0, 0); } } while (0)
            { const float kdum = ka; asm volatile("s_waitcnt vmcnt(0)" :: "v"(kdum) : "memory"); }
#pragma unroll
            for (int q = 0; q < 4; ++q) RW_ISSUE_Q(pi, q);
            asm volatile("s_waitcnt vmcnt(9)" ::: "memory"); RW_BAR();
            for (int z = 0; z < pi; ++z) { asm volatile("s_waitcnt vmcnt(9)" ::: "memory"); RW_BAR(); }
#pragma unroll 1
            for (int m = 0; m < 36; ++m) {
                const int c = pi + 4 * m;
                LAS unsigned char* S = C.lds + RW_RAW + (c % 5) * RW_SLOT;
                float cum = 0.f, emp = 1.0f, kdi_[16], bi_[16]; unsigned gv[16];
#pragma unroll
                for (int q = 0; q < 4; ++q) {
                    const LAS bf16_t* rw = (const LAS bf16_t*)raw + q * 3 * 512 + C.lane;
                    unsigned gr[4], gk[4], gkk[4], ge[4], gi[4];
#pragma unroll
                    for (int t = 0; t < 4; ++t) { gr[t] = rw[(0 * 8 + 0 + t) * 64]; gk[t] = rw[(0 * 8 + 4 + t) * 64]; gv[4 * q + t] = rw[(1 * 8 + 0 + t) * 64]; gkk[t] = rw[(1 * 8 + 4 + t) * 64]; ge[t] = rw[(2 * 8 + 0 + t) * 64]; gi[t] = rw[(2 * 8 + 4 + t) * 64]; }
                    __builtin_amdgcn_sched_barrier(0);
#pragma unroll
                    for (int t = 0; t < 4; ++t) { const int tt = 4 * q + t; const float r_ = bflo(gr[t]), k_ = bflo(gk[t]), kk_ = bflo(gkk[t]), e_ = bflo(ge[t]), a_ = bflo(gi[t]);
                        const float kd_ = k_ * (1.0f + (a_ - 1.0f) * ka), bb_ = kk_ * a_; cum += e_;
                        const float ep = __expf(cum), em = __expf(-cum); const float kkd = kk_ * emp, rd = r_ * em, kdi = kd_ * ep, bi = bb_ * ep; emp = em; kdi_[tt] = kdi; bi_[tt] = bi;
                        LAS bf16_t* rowp = (LAS bf16_t*)S + tt * 68 + C.lane;
                        const unsigned p0 = pkb(kkd, rd), p1 = pkb(kdi, bi);
                        rowp[0] = (bf16_t)(p0 & 0xffffu); rowp[1088] = (bf16_t)(p0 >> 16); rowp[2176] = (bf16_t)(p1 & 0xffffu); rowp[3264] = (bf16_t)(p1 >> 16); }
                    if (q == 3) { const float em15 = emp; unsigned wv[8], wk[8], wb[8];
#pragma unroll
                        for (int t2 = 0; t2 < 8; ++t2) {
                            wv[t2] = gv[2 * t2] | (gv[2 * t2 + 1] << 16); wk[t2] = pkb(kdi_[2 * t2] * em15, kdi_[2 * t2 + 1] * em15); wb[t2] = pkb(bi_[2 * t2] * em15, bi_[2 * t2 + 1] * em15); }
                        LAS u32x4* tv = (LAS u32x4*)(S + 8704 + C.lane * 48); tv[0] = (u32x4){wv[0], wv[1], wv[2], wv[3]}; tv[1] = (u32x4){wv[4], wv[5], wv[6], wv[7]};
                        LAS u32x4* tk = (LAS u32x4*)(S + 11776 + C.lane * 48); tk[0] = (u32x4){wk[0], wk[1], wk[2], wk[3]}; tk[1] = (u32x4){wk[4], wk[5], wk[6], wk[7]};
                        LAS u32x4* tb = (LAS u32x4*)(S + 14848 + C.lane * 48); tb[0] = (u32x4){wb[0], wb[1], wb[2], wb[3]}; tb[1] = (u32x4){wb[4], wb[5], wb[6], wb[7]};
                        *(LAS float*)(S + 17920 + C.lane * 4) = em15; }
                    asm volatile("s_waitcnt lgkmcnt(0)" ::: "memory");
                    if (c + 4 < 144) RW_ISSUE_Q(c + 4, q);
                    else { _Pragma("unroll") for (int j3 = 0; j3 < 3; ++j3) __builtin_amdgcn_global_load_lds((const unsigned*)RK, (LAS unsigned*)(raw + (q * 3 + j3) * 1024), 16, 0, 0); }
                    asm volatile("s_waitcnt vmcnt(9)" ::: "memory");
                    RW_BAR();
                }
            }
            for (int z = 0; z < 4 - pi; ++z) { asm volatile("s_waitcnt vmcnt(9)" ::: "memory"); RW_BAR(); }
            asm volatile("s_waitcnt vmcnt(0)" ::: "memory");
#undef RW_ISSUE_Q
        }
    }
}

__device__ __forceinline__ void phase_rwkv_out(const Ctx& C, int l, int nrows) {
    const bf16_t* RK = WSP(bf16_t, WS_RKVK); const bf16_t* LO = WSP(bf16_t, WS_LOUT); const bf16_t* Y2 = WSP(bf16_t, WS_Y2); bf16_t* O = WSP(bf16_t, WS_YBR1);
    float lw[8], lb[8], ka[8], rk[8];
#pragma unroll
    for (int j = 0; j < 8; ++j) { const int c = l * 512 + C.lane * 8 + j; lw[j] = CIN(28)[c]; lb[j] = CIN(29)[c]; ka[j] = CIN(26)[c]; rk[j] = CIN(27)[c]; }
    const int stride = C.G * 8, r0 = C.bid * 8 + C.wave;
    if (r0 >= nrows) return;
    const int T = (nrows - r0 + 2 * stride - 1) / (2 * stride);
#define RO_LOAD(ld, t_) do { _Pragma("unroll") for (int q = 0; q < 2; ++q) { const int rq_ = r0 + (2 * (t_) + q) * stride; const int row = rq_ < nrows ? rq_ : nrows - 1; \
            ld[q][0] = *(const u32x4*)(Y2 + (size_t)row * 512 + C.lane * 8); ld[q][1] = *(const u32x4*)(Y2 + ((size_t)NT + row) * 512 + C.lane * 8); \
            ld[q][2] = *(const u32x4*)(RK + (size_t)row * 2048 + C.lane * 8); ld[q][3] = *(const u32x4*)(RK + (size_t)row * 2048 + 512 + C.lane * 8); ld[q][4] = *(const u32x4*)(RK + (size_t)row * 2048 + 1024 + C.lane * 8); \
            ld[q][5] = *(const u32x4*)(LO + (size_t)row * 2560 + 1024 + C.lane * 8); ld[q][6] = *(const u32x4*)(LO + (size_t)row * 2560 + 1536 + C.lane * 8); ld[q][7] = *(const u32x4*)(LO + (size_t)row * 2560 + 2048 + C.lane * 8); } } while (0)
#define RO_PROC(ld, t_) do { _Pragma("unroll") for (int q = 0; q < 2; ++q) { const int rq_ = r0 + (2 * (t_) + q) * stride; const int row = rq_ < nrows ? rq_ : nrows - 1; \
            float y[8], t[8], r[8], k[8], v[8], i0[8], i1[8], g[8]; \
            unpack8(ld[q][0], y); unpack8(ld[q][1], t); unpack8(ld[q][2], r); unpack8(ld[q][3], k); unpack8(ld[q][4], v); unpack8(ld[q][5], i0); unpack8(ld[q][6], i1); unpack8(ld[q][7], g); \
            float s = 0.f, bs = 0.f; \
            _Pragma("unroll") for (int j = 0; j < 8; ++j) { y[j] += t[j]; s += y[j]; bs += r[j] * k[j] * (2.0f + (i0[j] + i1[j] - 2.0f) * ka[j]) * rk[j]; } \
            const float mean = red8(s) * (1.0f / 64.0f); bs = red8(bs); float qq = 0.f; \
            _Pragma("unroll") for (int j = 0; j < 8; ++j) { y[j] -= mean; qq += y[j] * y[j]; } \
            const float rstd = rsqrtf(red8(qq) * (1.0f / 64.0f) + GN_EPS); float o[8]; \
            _Pragma("unroll") for (int j = 0; j < 8; ++j) o[j] = (y[j] * rstd * lw[j] + lb[j] + bs * v[j]) * g[j]; \
            *(u32x4*)(O + (size_t)row * 512 + C.lane * 8) = pack8(o); } } while (0)
    u32x4 la[2][8], lb2[2][8];
    RO_LOAD(la, 0);
    int tt = 0;
    for (; tt + 1 < T; tt += 2) { RO_LOAD(lb2, tt + 1); RO_PROC(la, tt); RO_LOAD(la, tt + 2); RO_PROC(lb2, tt + 1); }
    if (tt < T) RO_PROC(la, tt);
#undef RO_LOAD
#undef RO_PROC
}

__device__ __forceinline__ void phase_mla_post(const Ctx& C, int l) {
    const bf16_t* P = WSP(bf16_t, WS_P); const bf16_t* QR = WSP(bf16_t, WS_QRAW); const bf16_t* KV = WSP(bf16_t, WS_KVRAW);
    bf16_t* Q = WSP(bf16_t, WS_Q); bf16_t* K = WSP(bf16_t, WS_K); bf16_t* V = WSP(bf16_t, WS_V);
    const int h = C.lane >> 3, sub = C.lane & 7;
    float gqn[8], gkn[8], gqr[4], gkr[4], frq[4];
#pragma unroll
    for (int j = 0; j < 8; ++j) { gqn[j] = CIN(34)[l * 64 + sub * 8 + j]; gkn[j] = CIN(35)[l * 64 + sub * 8 + j]; }
#pragma unroll
    for (int j = 0; j < 4; ++j) { gqr[j] = CIN(36)[l * 32 + sub * 4 + j]; gkr[j] = CIN(37)[l * 32 + sub * 4 + j]; const int i = (sub & 3) * 4 + j; frq[j] = exp2f(-(float)(i & 7) * (13.287712379549449f / 8.0f)); }
    const int stride = C.G * 8; const u32x4 z4 = (u32x4){0u, 0u, 0u, 0u};
    u32x4 n_pq = z4, n_pkv = z4, n_qn, n_kn, n_vv; u32x2 n_kr, n_qr;
#define MP_LOAD(rw_) do { const bf16_t* pr_ = P + (size_t)(rw_) * LDP; if (C.lane < 48) n_pq = *(const u32x4*)(pr_ + PC_MLA + C.lane * 8); if (C.lane < 32) n_pkv = *(const u32x4*)(pr_ + PC_CKV + C.lane * 8); \
        n_kr = *(const u32x2*)(pr_ + PC_KR + sub * 4); n_qn = *(const u32x4*)(QR + (size_t)(rw_) * 768 + h * 96 + sub * 8); n_qr = *(const u32x2*)(QR + (size_t)(rw_) * 768 + h * 96 + 64 + sub * 4); \
        n_kn = *(const u32x4*)(KV + (size_t)(rw_) * 1024 + h * 128 + sub * 8); n_vv = *(const u32x4*)(KV + (size_t)(rw_) * 1024 + h * 128 + 64 + sub * 8); } while (0)
    if (C.bid * 8 + C.wave < NT) MP_LOAD(C.bid * 8 + C.wave);
    for (int row = C.bid * 8 + C.wave; row < NT; row += stride) {
        const bool lat = row < NL; const int t = row & 2047;
        const u32x4 c_pq = n_pq, c_pkv = n_pkv, c_qn = n_qn, c_kn = n_kn, c_vv = n_vv; const u32x2 c_kr = n_kr, c_qr = n_qr;
        if (row + stride < NT) MP_LOAD(row + stride);
        float f[8]; float sq = 0.f, skv = 0.f;
        if (C.lane < 48) { unpack8(c_pq, f);
#pragma unroll
            for (int j = 0; j < 8; ++j) sq += f[j] * f[j]; }
        if (C.lane < 32) { unpack8(c_pkv, f);
#pragma unroll
            for (int j = 0; j < 8; ++j) skv += f[j] * f[j]; }
        const float rq = rsqrtf(red64(sq) * (1.0f / 384.0f) + NORM_EPS), rkv = rsqrtf(red64(skv) * (1.0f / 256.0f) + NORM_EPS);
        float cs[4], sn[4];
#pragma unroll
        for (int j = 0; j < 4; ++j) { if (lat) { const int i = (sub & 3) * 4 + j; const float pos = (float)(i < 8 ? (t >> 6) : (t & 63)); const float ang = pos * frq[j]; sn[j] = __sinf(ang); cs[j] = __cosf(ang); } else { cs[j] = 1.f; sn[j] = 0.f; } }
        float kr[4]; { const u32x2 w = c_kr; kr[0] = bflo(w.x); kr[1] = bfhi(w.x); kr[2] = bflo(w.y); kr[3] = bfhi(w.y); }
        { float s = kr[0] * kr[0] + kr[1] * kr[1] + kr[2] * kr[2] + kr[3] * kr[3]; const float rn = rsqrtf(red8(s) * (1.0f / 32.0f) + NORM_EPS);
#pragma unroll
          for (int j = 0; j < 4; ++j) kr[j] *= rn * gkr[j];
#pragma unroll
          for (int j = 0; j < 4; ++j) { const float pt = __shfl_xor(kr[j], 4); const float own = kr[j]; kr[j] = sub < 4 ? own * cs[j] - pt * sn[j] : pt * sn[j] + own * cs[j]; } }
        { float qn[8]; unpack8(c_qn, qn); float s = 0.f;
#pragma unroll
          for (int j = 0; j < 8; ++j) { qn[j] *= rq; s += qn[j] * qn[j]; }
          const float rn = rsqrtf(red8(s) * (1.0f / 64.0f) + NORM_EPS) * QSCALE;
#pragma unroll
          for (int j = 0; j < 8; ++j) qn[j] *= rn * gqn[j];
          *(u32x4*)(Q + ((size_t)row * 8 + h) * 96 + sub * 8) = pack8(qn);
          float qr[4]; { const u32x2 w = c_qr; qr[0] = bflo(w.x) * rq; qr[1] = bfhi(w.x) * rq; qr[2] = bflo(w.y) * rq; qr[3] = bfhi(w.y) * rq; }
          float s2 = qr[0] * qr[0] + qr[1] * qr[1] + qr[2] * qr[2] + qr[3] * qr[3]; const float rn2 = rsqrtf(red8(s2) * (1.0f / 32.0f) + NORM_EPS);
#pragma unroll
          for (int j = 0; j < 4; ++j) qr[j] *= rn2 * gqr[j];
#pragma unroll
          for (int j = 0; j < 4; ++j) { const float pt = __shfl_xor(qr[j], 4); const float own = qr[j]; qr[j] = (sub < 4 ? own * cs[j] - pt * sn[j] : pt * sn[j] + own * cs[j]) * QSCALE; }
          u32x2 w; w.x = pk2(qr[0], qr[1]); w.y = pk2(qr[2], qr[3]); *(u32x2*)(Q + ((size_t)row * 8 + h) * 96 + 64 + sub * 4) = w; }
        { float kn[8]; unpack8(c_kn, kn); float s = 0.f;
#pragma unroll
          for (int j = 0; j < 8; ++j) { kn[j] *= rkv; s += kn[j] * kn[j]; }
          const float rn = rsqrtf(red8(s) * (1.0f / 64.0f) + NORM_EPS);
#pragma unroll
          for (int j = 0; j < 8; ++j) kn[j] *= rn * gkn[j];
          *(u32x4*)(K + ((size_t)row * 8 + h) * 96 + sub * 8) = pack8(kn);
          u32x2 w; w.x = pk2(kr[0], kr[1]); w.y = pk2(kr[2], kr[3]); *(u32x2*)(K + ((size_t)row * 8 + h) * 96 + 64 + sub * 4) = w;
          float vv[8]; unpack8(c_vv, vv);
#pragma unroll
          for (int j = 0; j < 8; ++j) vv[j] *= rkv;
          *(u32x4*)(V + ((size_t)row * 8 + h) * 64 + sub * 8) = pack8(vv); }
    }
#undef MP_LOAD
}

__device__ __forceinline__ void phase_merge_sum(const Ctx& C, int nrows) {
    const bf16_t* P = WSP(bf16_t, WS_P); const bf16_t* BR = WSP(bf16_t, WS_BR); bf16_t* O = WSP(bf16_t, WS_MERGED);
    const int stride = C.G * 8, r0 = C.bid * 8 + C.wave;
    if (r0 < nrows) {
#define MS_LOAD(b, g, rw_) do { const int rq_ = (rw_); const int rw = rq_ < nrows ? rq_ : nrows - 1; const unsigned char* gp = (const unsigned char*)(P + (size_t)rw * LDP + PC_GATE);     \
        _Pragma("unroll") for (int j = 0; j < 3; ++j) _Pragma("unroll") for (int i = 0; i < 2; ++i) { const int col = 8 * C.lane + 512 * i; b[j][i] = *(const u32x4*)(BR + ((size_t)j * NT + rw) * 1024 + col); g[j][i] = *(const u32x2*)(gp + j * 1024 + col); } } while (0)
#define MS_PROC(b, g, rw_) do { const int rq_ = (rw_); const int row = rq_ < nrows ? rq_ : nrows - 1;     \
        _Pragma("unroll") for (int i = 0; i < 2; ++i) { float o[8]; \
            _Pragma("unroll") for (int q = 0; q < 8; ++q) o[q] = 0.f; \
            _Pragma("unroll") for (int j = 0; j < 3; ++j) { float bv[8], gv[8]; unpack8(b[j][i], bv); \
                { typedef float f32x2_ __attribute__((ext_vector_type(2))); const f32x2_ p0 = __builtin_amdgcn_cvt_pk_f32_fp8((int)g[j][i].x, false), p1 = __builtin_amdgcn_cvt_pk_f32_fp8((int)g[j][i].x, true), \
                    p2 = __builtin_amdgcn_cvt_pk_f32_fp8((int)g[j][i].y, false), p3 = __builtin_amdgcn_cvt_pk_f32_fp8((int)g[j][i].y, true); \
                  gv[0] = p0[0]; gv[1] = p0[1]; gv[2] = p1[0]; gv[3] = p1[1]; gv[4] = p2[0]; gv[5] = p2[1]; gv[6] = p3[0]; gv[7] = p3[1]; } \
                _Pragma("unroll") for (int q = 0; q < 8; ++q) o[q] += sigmoidf_(gv[q] * (1.0f / F8_SG)) * bv[q]; } \
            *(u32x4*)(O + (size_t)row * 1024 + 8 * C.lane + 512 * i) = pack8(o); } } while (0)
        u32x4 ba[3][2], bb[3][2]; u32x2 ga[3][2], gb[3][2];
        MS_LOAD(ba, ga, r0);
        for (int rr = r0; rr < nrows; rr += 2 * stride) { MS_LOAD(bb, gb, rr + stride); MS_PROC(ba, ga, rr); MS_LOAD(ba, ga, rr + 2 * stride); MS_PROC(bb, gb, rr + stride); }
#undef MS_LOAD
#undef MS_PROC
    }
}

__device__ __forceinline__ void phase_attn(const Ctx& C, int nunits) {
    const bf16_t* Q = WSP(bf16_t, WS_Q); const bf16_t* K = WSP(bf16_t, WS_K); const bf16_t* V = WSP(bf16_t, WS_V); bf16_t* O = WSP(bf16_t, WS_YBR2);
    LAS bf16_t* Kb = (LAS bf16_t*)C.lds;
    LAS bf16_t* Vb = Kb + 2 * 64 * 104;
    const int fr = C.lane & 15, g = C.lane >> 4, skey = C.tid >> 3, spc = C.tid & 7;
    for (int u = C.bid; u < nunits; u += C.G) {
        const bool lat = u < 1024; const int b = lat ? (u >> 6) : ((u - 1024) >> 3), h = lat ? ((u >> 3) & 7) : ((u - 1024) & 7), qt = lat ? (u & 7) : 0;
        const int qbase = (lat ? b * 2048 + qt * 256 : NL + b * 256) + C.wave * 32; const int nkt = lat ? 36 : 4;
        bf16x8 bq[2][3];
#pragma unroll
        for (int qi = 0; qi < 2; ++qi)
#pragma unroll
            for (int ks = 0; ks < 3; ++ks) bq[qi][ks] = *(const bf16x8*)(Q + ((size_t)(qbase + qi * 16 + fr) * 8 + h) * 96 + ks * 32 + g * 8);
        float mrun[2] = {0.f, 0.f};
        f32x4 ot[5][2];
#pragma unroll
        for (int dt = 0; dt < 5; ++dt) { ot[dt][0] = (f32x4){0.f, 0.f, 0.f, 0.f}; ot[dt][1] = ot[dt][0]; }
        const bf16x8 ones8 = __builtin_bit_cast(bf16x8, (u32x4){0x3f803f80u, 0x3f803f80u, 0x3f803f80u, 0x3f803f80u});
        u32x4 k0, k1, v0;
#define AT_LOAD(kt) do { const int tok_ = (((kt) < 4) ? NL + b * 256 + (kt) * 64 : b * 2048 + ((kt) - 4) * 64) + skey; const bf16_t* kp_ = K + ((size_t)tok_ * 8 + h) * 96; \
        k0 = *(const u32x4*)(kp_ + spc * 8); k1 = spc < 4 ? *(const u32x4*)(kp_ + 64 + spc * 8) : (u32x4){0u, 0u, 0u, 0u}; v0 = *(const u32x4*)(V + ((size_t)tok_ * 8 + h) * 64 + spc * 8); } while (0)
#define AT_WRITE(bufi) do { LAS bf16_t* kd_ = Kb + (bufi) * 6656 + skey * 104; *(LAS u32x4*)(kd_ + spc * 8) = k0; if (spc < 4) *(LAS u32x4*)(kd_ + 64 + spc * 8) = k1; \
        *(LAS u32x4*)(Vb + (bufi) * 4608 + skey * 72 + spc * 8) = v0; } while (0)
        AT_LOAD(0); AT_WRITE(0);
        __syncthreads();
        for (int kt = 0; kt < nkt; ++kt) {
            const int bi = kt & 1;
            if (kt + 1 < nkt) AT_LOAD(kt + 1);
            const LAS bf16_t* Kc = Kb + bi * 6656; const LAS bf16_t* Vc = Vb + bi * 4608;
            f32x4 st[2][4];
#pragma unroll
            for (int k4 = 0; k4 < 4; ++k4) { st[0][k4] = (f32x4){-mrun[0], -mrun[0], -mrun[0], -mrun[0]}; st[1][k4] = (f32x4){-mrun[1], -mrun[1], -mrun[1], -mrun[1]}; }
#pragma unroll
            for (int k4 = 0; k4 < 4; ++k4)
#pragma unroll
                for (int ks = 0; ks < 3; ++ks) { const bf16x8 a = *(const LAS bf16x8*)(Kc + (k4 * 16 + fr) * 104 + ks * 32 + g * 8);
                    st[0][k4] = __builtin_amdgcn_mfma_f32_16x16x32_bf16(a, bq[0][ks], st[0][k4], 0, 0, 0); st[1][k4] = __builtin_amdgcn_mfma_f32_16x16x32_bf16(a, bq[1][ks], st[1][k4], 0, 0, 0);
                    if (ks == 2 && (k4 & 1)) __builtin_amdgcn_sched_barrier(0); }
            bf16x8 bp[2][2];
#pragma unroll
            for (int qi = 0; qi < 2; ++qi) {
                float mx = st[qi][0][0];
#pragma unroll
                for (int k4 = 0; k4 < 4; ++k4)
#pragma unroll
                    for (int r = 0; r < 4; ++r) mx = fmaxf(mx, st[qi][k4][r]);
                if (!__all(mx <= 8.0f)) { mx = fmaxf(mx, __shfl_xor(mx, 16)); mx = fmaxf(mx, __shfl_xor(mx, 32)); const float dlt = mx; const float alpha = __builtin_amdgcn_exp2f(-dlt); mrun[qi] += dlt;
#pragma unroll
                    for (int dt = 0; dt < 5; ++dt) ot[dt][qi] *= alpha;
#pragma unroll
                    for (int k4 = 0; k4 < 4; ++k4) st[qi][k4] -= dlt; }
#pragma unroll
                for (int k4 = 0; k4 < 4; ++k4)
#pragma unroll
                    for (int r = 0; r < 4; ++r) st[qi][k4][r] = __builtin_amdgcn_exp2f(st[qi][k4][r]);
#pragma unroll
                for (int kb = 0; kb < 2; ++kb) { u32x4 w; w.x = pk2(st[qi][2 * kb][0], st[qi][2 * kb][1]); w.y = pk2(st[qi][2 * kb][2], st[qi][2 * kb][3]); w.z = pk2(st[qi][2 * kb + 1][0], st[qi][2 * kb + 1][1]); w.w = pk2(st[qi][2 * kb + 1][2], st[qi][2 * kb + 1][3]);
                    bp[qi][kb] = __builtin_bit_cast(bf16x8, w); }
                __builtin_amdgcn_sched_barrier(0);
            }
            {
                const unsigned vaddr = (unsigned)(size_t)(Vc + (4 * g + (fr >> 2)) * 72 + 4 * (fr & 3));
                u32x2 vt[4][2][2];
#define AT_TR(dt, kb, hh) "ds_read_b64_tr_b16 %" #dt #kb #hh ", %[a] offset:"
                asm volatile(
                    "ds_read_b64_tr_b16 %0, %16 offset:0\n\tds_read_b64_tr_b16 %1, %16 offset:2304\n\tds_read_b64_tr_b16 %2, %16 offset:4608\n\tds_read_b64_tr_b16 %3, %16 offset:6912\n\t"
                    "ds_read_b64_tr_b16 %4, %16 offset:32\n\tds_read_b64_tr_b16 %5, %16 offset:2336\n\tds_read_b64_tr_b16 %6, %16 offset:4640\n\tds_read_b64_tr_b16 %7, %16 offset:6944\n\t"
                    "ds_read_b64_tr_b16 %8, %16 offset:64\n\tds_read_b64_tr_b16 %9, %16 offset:2368\n\tds_read_b64_tr_b16 %10, %16 offset:4672\n\tds_read_b64_tr_b16 %11, %16 offset:6976\n\t"
                    "ds_read_b64_tr_b16 %12, %16 offset:96\n\tds_read_b64_tr_b16 %13, %16 offset:2400\n\tds_read_b64_tr_b16 %14, %16 offset:4704\n\tds_read_b64_tr_b16 %15, %16 offset:7008\n\t"
                    "s_waitcnt lgkmcnt(0)"
                    : "=&v"(vt[0][0][0]), "=&v"(vt[0][0][1]), "=&v"(vt[0][1][0]), "=&v"(vt[0][1][1]), "=&v"(vt[1][0][0]), "=&v"(vt[1][0][1]), "=&v"(vt[1][1][0]), "=&v"(vt[1][1][1]),
                      "=&v"(vt[2][0][0]), "=&v"(vt[2][0][1]), "=&v"(vt[2][1][0]), "=&v"(vt[2][1][1]), "=&v"(vt[3][0][0]), "=&v"(vt[3][0][1]), "=&v"(vt[3][1][0]), "=&v"(vt[3][1][1])
                    : "v"(vaddr) : "memory");
#undef AT_TR
#pragma unroll
                for (int dt = 0; dt < 4; ++dt)
#pragma unroll
                    for (int kb = 0; kb < 2; ++kb) { const bf16x8 a = __builtin_bit_cast(bf16x8, (u32x4){vt[dt][kb][0].x, vt[dt][kb][0].y, vt[dt][kb][1].x, vt[dt][kb][1].y});
                        ot[dt][0] = __builtin_amdgcn_mfma_f32_16x16x32_bf16(a, bp[0][kb], ot[dt][0], 0, 0, 0); ot[dt][1] = __builtin_amdgcn_mfma_f32_16x16x32_bf16(a, bp[1][kb], ot[dt][1], 0, 0, 0); }
#pragma unroll
                for (int kb = 0; kb < 2; ++kb) { ot[4][0] = __builtin_amdgcn_mfma_f32_16x16x32_bf16(ones8, bp[0][kb], ot[4][0], 0, 0, 0); ot[4][1] = __builtin_amdgcn_mfma_f32_16x16x32_bf16(ones8, bp[1][kb], ot[4][1], 0, 0, 0); }
            }
            if (kt + 1 < nkt) AT_WRITE(bi ^ 1);
            __syncthreads();
        }
#pragma unroll
        for (int qi = 0; qi < 2; ++qi) { const float inv = __builtin_amdgcn_rcpf(ot[4][qi][0]);
            bf16_t* op = O + (size_t)(qbase + qi * 16 + fr) * 512 + h * 64 + 4 * g;
#pragma unroll
            for (int dt = 0; dt < 4; ++dt) { const f32x4 o = ot[dt][qi] * inv; u32x2 w; w.x = pk2(o[0], o[1]); w.y = pk2(o[2], o[3]); *(u32x2*)(op + dt * 16) = w; } }
#undef AT_LOAD
#undef AT_WRITE
    }
}

#ifndef PROBE_BODIES
#define PROBE_BODIES 0u
#endif
#ifndef MK_PER_PHASE
#define MK_PER_PHASE 0
#endif
constexpr int NPH_LAYER = 13, PH_FINAL = 1 + NPH_LAYER * DEPTH, NPHASES = PH_FINAL + 1;

__global__ void __launch_bounds__(NTHREADS, 2) trunk_fwd(Args args) {
    extern __shared__ __attribute__((aligned(16))) unsigned char lds_raw[];
    Ctx C;
    C.A = (const __attribute__((address_space(4))) Args*)__builtin_amdgcn_kernarg_segment_ptr();
    C.out = args.out; C.ws = args.ws; C.lds = (LAS unsigned char*)lds_raw;
    C.tid = threadIdx.x; C.lane = C.tid & 63; C.wave = __builtin_amdgcn_readfirstlane(C.tid >> 6); C.G = gridDim.x; C.bid = blockIdx.x;
    LAS unsigned char* lds = C.lds;
    volatile LAS unsigned* misc = (volatile LAS unsigned*)(lds + LDS_BYTES - 64);
    if (C.tid < 4) misc[C.tid] = 0u;
    __syncthreads();
    XcdBarrier bar = xcd_barrier_post((unsigned*)(C.ws + WS_CTL) + 4096, misc);
#define SEAM() xcd_barrier(bar)
    const int lo = args.ph_lo, hi = args.ph_hi; const unsigned bmask = args.bmask;
#define BODY(k) if (bmask & (1u << (k)))
#define FRESH() do { const __attribute__((address_space(4))) Args* a_ = (const __attribute__((address_space(4))) Args*)__builtin_amdgcn_kernarg_segment_ptr(); \
        GAS unsigned char* w_ = (GAS unsigned char*)args.ws; GAS float* o_ = (GAS float*)args.out; int t_ = threadIdx.x; asm volatile("" : "+s"(a_), "+s"(w_), "+s"(o_), "+v"(t_)); \
        C.A = a_; C.ws = (unsigned char*)w_; C.out = (float*)o_; C.tid = t_; C.lane = t_ & 63; C.wave = __builtin_amdgcn_readfirstlane(t_ >> 6); } while (0)
#ifndef PHDIS
#define PHDIS 0
#endif
#define PHEN(k) (!((PHDIS >> (k)) & 1))
#define IN(k) (lo <= (k) && (k) < hi)
#define ENDPH(k) do { if (IN((k) + 1)) SEAM(); } while (0)

    if (IN(0)) { FRESH(); phase_ada(C); phase_ssm_prep(C); ENDPH(0); }

    for (int l = 0; l < DEPTH; ++l) {
        const int base = 1 + NPH_LAYER * l;
        if (base + NPH_LAYER <= lo || base >= hi) continue;
        const bool lastl = (l == DEPTH - 1);
        const int nMt = lastl ? NL / 256 : NT / 256, nrt = lastl ? NL : NT;
        const bool elem_first = (C.bid >> 3) & 1;
        if (PHEN(0) && IN(base + 0)) { FRESH(); BODY(0) { phase_conv_small(C, l); phase_router_prep(C, l); } BODY(1) phase_norm1(C, l); ENDPH(base + 0); }
        if (PHEN(1) && IN(base + 1)) { FRESH();
            BODY(2) { { pg8::Gemm g{WSP(bf16_t, WS_H), WSP(bf16_t, WS_WIN), 1024, 1024, 1024, 0, 0}; pg8::GroupOrder S; S.init(NT / 256, WIN_NB16, 1, C.G, C.bid);
              EpiWin E{WSP(bf16_t, WS_P), WSP(bf16_t, WS_UT), 0, 1.0f}; pg8::gemm_phase(lds, C.tid, g, S, E); }
              __syncthreads();
              { pg8::Gemm g{WSP(bf16_t, WS_H8), WSP(bf16_t, WS_WIN8) + (size_t)WIN_NB16 * 256 * 512, 1024, 1024, 1024, 0, 0};   pg8::GroupOrder S; S.init(NT / 256, 24 - WIN_NB16, 1, C.G, C.bid, (NT / 256 * WIN_NB16) % 256);
              EpiWin E{WSP(bf16_t, WS_P), WSP(bf16_t, WS_UT), WIN_NB16, 1.0f / (F8_SX * F8_SW)}; pg8::gemm_phase<EpiWin, pg8::GroupOrder, true>(lds, C.tid, g, S, E); } } ENDPH(base + 1); }
        if (PHEN(2) && IN(base + 2)) { FRESH();
            if (elem_first) { BODY(6) phase_rwkv_pre(C, l); __syncthreads(); }
            BODY(2) { pg8::Gemm g{WSP(bf16_t, WS_H8), WSP(bf16_t, WS_WIN8) + (size_t)6144 * 512, 1024, 1024, 1024, 0, 0};   pg8::GroupOrder S; S.init(NT / 256, 1, 1, C.G, C.bid);
              EpiWin E{WSP(bf16_t, WS_P), WSP(bf16_t, WS_UT), 24, 1.0f / (F8_SX * F8_SW)}; pg8::gemm_phase<EpiWin, pg8::GroupOrder, true>(lds, C.tid, g, S, E); }
            __syncthreads();
            BODY(3) { pg8::Gemm g{WSP(bf16_t, WS_UT), WSP(bf16_t, WS_W1S) + (size_t)l * 32 * 256 * 256, 512, 256, 256, (size_t)NCHROW * 512 * 2, (size_t)256 * 256 * 2}; pg8::GroupOrder S; S.init(NCHROW / 256, 1, 32, C.G, C.bid, 144);
              EpiSsmE E{WSP(float, WS_E)}; pg8::gemm_phase(lds, C.tid, g, S, E); }
            __syncthreads();
            BODY(4) { pg8::Gemm g{WSP(bf16_t, WS_P) + PC_MLA, WSP(bf16_t, WS_WUQ), LDP, 384, 384, 0, 0}; pg8::GroupOrder S; S.init(nMt, 3, 1, C.G, C.bid, 176);
              EpiBf16 E{WSP(bf16_t, WS_QRAW), 768, 0}; pg8::gemm_phase(lds, C.tid, g, S, E); }
            __syncthreads();
            BODY(5) { pg8::Gemm g{WSP(bf16_t, WS_P) + PC_CKV, WSP(bf16_t, WS_WUKV), LDP, 256, 256, 0, 0}; pg8::GroupOrder S; S.init(NT / 256, 4, 1, C.G, C.bid, 96);
              EpiBf16 E{WSP(bf16_t, WS_KVRAW), 1024, 0}; pg8::gemm_phase(lds, C.tid, g, S, E); }
            __syncthreads();
            if (!elem_first) { BODY(6) phase_rwkv_pre(C, l); }
            ENDPH(base + 2); }
        if (PHEN(3) && IN(base + 3)) { FRESH();
            if (elem_first) { BODY(9) phase_mla_post(C, l); __syncthreads(); }
            BODY(7) phase_ssm_step2(C, l);
            BODY(8) { int k128 = 128; asm volatile("" : "+s"(k128));
              { pg8::Gemm g{WSP(bf16_t, WS_LIN), WSP(bf16_t, WS_WLORA), 384, 128, k128, (size_t)128 * 2, (size_t)1024 * 128 * 2}; pg8::GroupOrder S; S.init(NT / 256, 4, 2, C.G, C.bid, 128);
                EpiLora E{WSP(bf16_t, WS_LOUT), CIN(20) + l * 1024, CIN(22) + l * 1024}; pg8::gemm_phase(lds, C.tid, g, S, E); }
              __syncthreads();
              { pg8::Gemm g{WSP(bf16_t, WS_LIN) + 256, WSP(bf16_t, WS_WLORA) + (size_t)2 * 1024 * 128, 384, 128, k128, 0, 0}; pg8::GroupOrder S; S.init(NT / 256, 2, 1, C.G, C.bid, 160);
                EpiBf16 E{WSP(bf16_t, WS_LOUT) + 2048, 2560, 0}; pg8::gemm_phase(lds, C.tid, g, S, E); } }
            __syncthreads();
            if (!elem_first) { BODY(9) phase_mla_post(C, l); }
            ENDPH(base + 3); }
        if (PHEN(4) && IN(base + 4)) { FRESH();
            BODY(10) phase_rwkv_scan(C, l);
            __syncthreads();
            BODY(11) phase_attn(C, lastl ? 1024 : 1152);
            __syncthreads();
            BODY(12) { pg8::Gemm g{WSP(bf16_t, WS_UT), WSP(bf16_t, WS_W3S) + (size_t)l * 32 * 256 * 512, 512, 512, 512, (size_t)NCHROW * 512 * 2, (size_t)256 * 512 * 2}; pg8::GroupOrder S; S.init(lastl ? 8 : 9, 1, 32, C.G, C.bid, 128);
              EpiSsmY E{WSP(bf16_t, WS_YG)}; pg8::gemm_phase(lds, C.tid, g, S, E); }
            ENDPH(base + 4); }
        if (PHEN(5) && IN(base + 5)) { FRESH();
            if (elem_first) { BODY(14) phase_rwkv_out(C, l, nrt); __syncthreads(); }
            BODY(13) { pg8::Gemm g{WSP(bf16_t, WS_YG), WSP(bf16_t, WS_WGLU), 512, 512, 512, 0, 0}; pg8::GroupOrder S; S.init(nMt, 2, 1, C.G, C.bid);
              EpiGlu E{WSP(bf16_t, WS_YG), CIN(18) + l * 512, WSP(bf16_t, WS_YBR0)}; pg8::gemm_phase(lds, C.tid, g, S, E); }
            __syncthreads();
            if (!elem_first) { BODY(14) phase_rwkv_out(C, l, nrt); }
            ENDPH(base + 5); }
        if (PHEN(6) && IN(base + 6)) { FRESH();
            BODY(15) { pg8::Gemm g{WSP(bf16_t, WS_YBR0), WSP(bf16_t, WS_WBR), 512, 512, 512, YBR_STRIDE, (size_t)1024 * 512 * 2}; pg8::GroupOrder S; S.init(nMt, 4, 3, C.G, C.bid);
            EpiBf16 E{WSP(bf16_t, WS_BR), 1024, (size_t)NT * 1024}; pg8::gemm_phase(lds, C.tid, g, S, E); } ENDPH(base + 6); }
        if (PHEN(7) && IN(base + 7)) { FRESH(); BODY(23) phase_merge_sum(C, nrt); ENDPH(base + 7); }
        if (PHEN(8) && IN(base + 8)) { FRESH();
            BODY(16) { pg8::Gemm g{WSP(bf16_t, WS_MERGED), WSP(bf16_t, WS_WOUT), 1024, 1024, 1024, 0, 0}; pg8::GroupOrder S; S.init(nMt, 4, 1, C.G, C.bid);
            EpiWout E{WSP(bf16_t, WS_XB), WSP(float, WS_MOD) + (size_t)l * 17 * 6144}; pg8::gemm_phase(lds, C.tid, g, S, E); } ENDPH(base + 8); }
        if (PHEN(9) && IN(base + 9)) { FRESH(); BODY(17) phase_norm2(C, l, nrt); BODY(18) phase_conv_moe(C, l); ENDPH(base + 9); }
        if (PHEN(10) && IN(base + 10)) { FRESH(); BODY(19) phase_topk(C, lastl ? 256 : 512); ENDPH(base + 10); }
        if (PHEN(11) && IN(base + 11)) { FRESH();
            BODY(21) { pg8::Gemm g{WSP(bf16_t, WS_XS), WSP(bf16_t, WS_W13), 1024, 1024, 1024, (size_t)EROWS * 1024, (size_t)3072 * 1024};   pg8::GroupOrder S; S.init(lastl ? 16 : EROWS / 256, 12, 16, C.G, C.bid);
            EpiMoe1 E{WSP(unsigned char, WS_HID)}; pg8::gemm_phase<EpiMoe1, pg8::GroupOrder, true>(lds, C.tid, g, S, E); } ENDPH(base + 11); }
        if (PHEN(12) && IN(base + 12)) { FRESH();
            BODY(22) { pg8::Gemm g{WSP(bf16_t, WS_HID), WSP(bf16_t, WS_W2), HS, HS, FF, (size_t)EROWS * HS, (size_t)1024 * HS};   pg8::GroupOrder S; S.init(lastl ? 16 : EROWS / 256, 4, 16, C.G, C.bid);
            EpiMoe2 E{WSP(bf16_t, WS_YBUF), WSP(float, WS_GATE)}; pg8::gemm_phase<EpiMoe2, pg8::GroupOrder, true>(lds, C.tid, g, S, E); } ENDPH(base + 12); }
    }
    if (IN(PH_FINAL)) { FRESH(); phase_final(C); }
#undef IN
#undef ENDPH
#undef SEAM
}

extern "C" void kernel_launch(void* const* d_in, const int* in_sizes, int n_in, void* d_out, int out_size, void* d_ws, size_t ws_size, hipStream_t stream) {
    static int grid = 0;
    if (grid == 0) {
        if (n_in != 44 || ws_size < WS_END) { fprintf(stderr, "kernel_launch: unexpected n_in %d or ws_size %zu (need %zu)\n", n_in, ws_size, (size_t)WS_END); grid = -1; return; }
        int dev = 0, cus = 0, per_cu = 0;
        if (hipGetDevice(&dev) != hipSuccess || hipDeviceGetAttribute(&cus, hipDeviceAttributeMultiprocessorCount, dev) != hipSuccess) { grid = -1; return; }
        if (hipFuncSetAttribute((const void*)trunk_fwd, hipFuncAttributeMaxDynamicSharedMemorySize, LDS_BYTES) != hipSuccess) { fprintf(stderr, "kernel_launch: hipFuncSetAttribute failed\n"); grid = -1; return; }
        if (hipOccupancyMaxActiveBlocksPerMultiprocessor(&per_cu, (const void*)trunk_fwd, NTHREADS, LDS_BYTES) != hipSuccess || per_cu < 1) fprintf(stderr, "kernel_launch: occupancy query says %d\n", per_cu);
        (void)hipGetLastError();
        grid = cus;
    }
    if (grid < 0) return;
    (void)hipMemsetAsync((char*)d_ws + WS_CTL, 0, CTL_BYTES, stream);
    Args a{};
    for (int i = 0; i < 44; ++i) a.in[i] = (const float*)d_in[i];
    a.out = (float*)d_out; a.ws = (unsigned char*)d_ws; a.bmask = 0xffffffffu;
#if MK_PER_PHASE
    for (int ph = 0; ph < NPHASES; ++ph) { a.ph_lo = ph; a.ph_hi = ph + 1; hipLaunchKernelGGL(trunk_fwd, dim3(grid), dim3(NTHREADS), LDS_BYTES, stream, a);
        static const int body_phase[24] = {0, 0, 1, 2, 2, 2, 2, 3, 3, 3, 4, 4, 4, 5, 5, 6, 8, 9, 9, 10, 10, 11, 12, 7};
        bool hit = false; for (int b = 0; b < 24; ++b) if (((PROBE_BODIES >> b) & 1u) && ph >= 1 && ph < PH_FINAL && (ph - 1) % NPH_LAYER == body_phase[b]) hit = true;
        if (hit) { a.bmask = PROBE_BODIES; hipLaunchKernelGGL(trunk_fwd, dim3(grid), dim3(NTHREADS), LDS_BYTES, stream, a); a.bmask = 0xffffffffu; } }
#else
    a.ph_lo = 0; a.ph_hi = NPHASES; hipLaunchKernelGGL(trunk_fwd, dim3(grid), dim3(NTHREADS), LDS_BYTES, stream, a);
#endif
}
```
